# Optimizing an MI355X kernel written in HIP

```python
import math, functools
import jax, jax.numpy as jnp
from jax import lax
import numpy as np

D_MODEL = 1024
BATCH = 4
SEQ = 8192
DEPTH = 1

D_MIX = D_MODEL
N_ATT_HEADS = 8
HEAD_DIM = 64
D_ATT = N_ATT_HEADS * HEAD_DIM
D_POOL = D_MIX - D_ATT
POOL_WINDOWS = (2, 4, 8, 16)
N_POOL_GROUPS = len(POOL_WINDOWS)
POOL_GROUP = D_POOL // N_POOL_GROUPS
DILATED_BRANCHES = ((128, 1), (512, 4), (2048, 16))
MAX_DIL = 16
BLOCK = 128
ROPE_THETA = 10000.0
EPS = 1e-6
N_KEYS = 128
N_EXPERTS = N_KEYS * N_KEYS
PEER_HEADS = 8
PEER_KEY_DIM = 256
PEER_HALF = PEER_KEY_DIM // 2
PEER_TOPK = 16
PEER_CHUNK = 128

kernel_name = "hymba_dilated_pool_peer_block"


def _rmsnorm(x, g):
    xf = x.astype(jnp.float32)
    y = xf * lax.rsqrt(jnp.mean(xf * xf, axis=-1, keepdims=True) + EPS)
    return (y * g.astype(jnp.float32)).astype(x.dtype)


def _rope(x, pos):
    hd = x.shape[-1]
    freqs = ROPE_THETA ** (-jnp.arange(0, hd, 2, dtype=jnp.float32) / hd)
    ang = pos[:, None] * freqs[None, :]
    cos = jnp.cos(ang)[None, :, None, :]
    sin = jnp.sin(ang)[None, :, None, :]
    xf = x.astype(jnp.float32)
    x1, x2 = xf[..., : hd // 2], xf[..., hd // 2:]
    return jnp.concatenate([x1 * cos - x2 * sin, x2 * cos + x1 * sin], axis=-1)


def _dilated_branch(q, k, v, dil, n_back):
    B, H, Sp, hd = q.shape
    L = Sp // dil
    nb = L // BLOCK

    def to_blocks(t):
        t = t.reshape(B, H, L, dil, hd).transpose(0, 1, 3, 2, 4)
        return t.reshape(B, H, dil, nb, BLOCK, hd)

    def with_prev(t):
        prev = jnp.pad(t, ((0, 0), (0, 0), (0, 0), (1, 0), (0, 0), (0, 0)))[:, :, :, :nb]
        return jnp.concatenate([prev, t], axis=4)

    qb = to_blocks(q)
    kc = with_prev(to_blocks(k))
    vc = with_prev(to_blocks(v))
    s = jnp.einsum('bhrnqd,bhrnkd->bhrnqk', qb, kc)
    a = jnp.arange(BLOCK)[:, None]
    c = jnp.arange(2 * BLOCK)[None, :]
    dist = a - c + BLOCK
    kidx = jnp.arange(nb)[:, None, None] * BLOCK + c[None] - BLOCK
    valid = (dist >= 0) & (dist <= n_back) & (kidx >= 0)
    s = jnp.where(valid, s, -jnp.inf)
    m = jnp.max(s, axis=-1, keepdims=True)
    p = jnp.exp(s - m)
    l = jnp.sum(p, axis=-1, keepdims=True)
    o = jnp.einsum('bhrnqk,bhrnkd->bhrnqd', p, vc) / l
    lse = (m + jnp.log(l))[..., 0]
    o = o.reshape(B, H, dil, L, hd).transpose(0, 1, 3, 2, 4).reshape(B, H, Sp, hd)
    lse = lse.reshape(B, H, dil, L).transpose(0, 1, 3, 2).reshape(B, H, Sp)
    return o, lse


def _dilated_attention(q, k, v):
    B, H, S, hd = q.shape
    unit = MAX_DIL * BLOCK
    Sp = -(-S // unit) * unit
    pad = ((0, 0), (0, 0), (0, Sp - S), (0, 0))
    q = jnp.pad(q * (HEAD_DIM ** -0.5), pad)
    k = jnp.pad(k, pad)
    v = jnp.pad(v, pad)
    outs, lses = [], []
    for window, dil in DILATED_BRANCHES:
        o_i, lse_i = _dilated_branch(q, k, v, dil, window // dil)
        outs.append(o_i)
        lses.append(lse_i)
    wts = jax.nn.softmax(jnp.stack(lses, axis=0), axis=0)
    o = jnp.einsum('gbhs,gbhsd->bhsd', wts, jnp.stack(outs, axis=0))
    return o[:, :, :S]


def _trailing_mean_minus_self(x, w):
    S = x.shape[1]
    csum = jnp.pad(jnp.cumsum(x, axis=1), ((0, 0), (1, 0), (0, 0)))
    hi = csum[:, 1:]
    lo = jnp.pad(csum, ((0, 0), (w - 1, 0), (0, 0)))[:, :S]
    cnt = jnp.minimum(jnp.arange(S) + 1, w).astype(jnp.float32)
    return (hi - lo) / cnt[None, :, None] - x


def _pool_mixer(p, pool_w, pool_scale):
    B, S, _ = p.shape
    pg = p.astype(jnp.float32).reshape(B, S, N_POOL_GROUPS, POOL_GROUP)
    pooled = jnp.stack([_trailing_mean_minus_self(pg[:, :, g], w)
                        for g, w in enumerate(POOL_WINDOWS)], axis=2)
    y = jnp.einsum('bsgc,gcd->bsgd', pooled, pool_w.astype(jnp.float32))
    return y.reshape(B, S, D_POOL) * pool_scale.astype(jnp.float32)


def _peer(h, w_query, sub_keys, expert_u, expert_v):
    B, S, D = h.shape
    T = B * S
    ht = h.reshape(T, D)
    q = (ht @ w_query).astype(jnp.float32).reshape(T, PEER_HEADS, 2, PEER_HALF)
    s = jnp.einsum('thpc,hpnc->thpn', q, sub_keys.astype(jnp.float32))
    s_top, i_top = lax.top_k(s, PEER_TOPK)
    cand = (s_top[:, :, 0, :, None] + s_top[:, :, 1, None, :]).reshape(T, PEER_HEADS, -1)
    cand_idx = (i_top[:, :, 0, :, None] * N_KEYS + i_top[:, :, 1, None, :]).reshape(T, PEER_HEADS, -1)
    best, pos = lax.top_k(cand, PEER_TOPK)
    idx = jnp.take_along_axis(cand_idx, pos, axis=-1)
    gate = jax.nn.softmax(best, axis=-1)
    n_chunks = T // PEER_CHUNK
    xs = (ht.reshape(n_chunks, PEER_CHUNK, D),
          idx.reshape(n_chunks, PEER_CHUNK, PEER_HEADS * PEER_TOPK),
          gate.reshape(n_chunks, PEER_CHUNK, PEER_HEADS * PEER_TOPK))

    def chunk_fn(args):
        xc, ic, gc = args
        u = expert_u[ic]
        a = jnp.einsum('ckd,cd->ck', u.astype(jnp.float32), xc.astype(jnp.float32))
        act = jax.nn.gelu(a, approximate=False) * gc
        vsel = expert_v[ic]
        return jnp.einsum('ck,ckd->cd', act, vsel.astype(jnp.float32))

    y = lax.map(chunk_fn, xs)
    return y.reshape(B, S, D)


def setup_inputs(seed: int = 0) -> dict:
    key = jax.random.key(seed)
    ks = jax.random.split(key, 14)
    f32 = jnp.float32
    nrm = lambda k, shape, scale: (jax.random.normal(k, shape, f32) * scale)
    return {
        "x": nrm(ks[0], (BATCH, SEQ, D_MODEL), 1.0),
        "attn_norm_g": 1.0 + nrm(ks[1], (DEPTH, D_MODEL), 0.1),
        "w_in": nrm(ks[2], (DEPTH, D_MODEL, 3 * D_ATT + D_POOL), D_MODEL ** -0.5),
        "q_norm_g": 1.0 + nrm(ks[3], (DEPTH, HEAD_DIM), 0.1),
        "k_norm_g": 1.0 + nrm(ks[4], (DEPTH, HEAD_DIM), 0.1),
        "pool_w": nrm(ks[5], (DEPTH, N_POOL_GROUPS, POOL_GROUP, POOL_GROUP), POOL_GROUP ** -0.5),
        "pool_scale": 1.0 + nrm(ks[6], (DEPTH, D_POOL), 0.1),
        "w_out": nrm(ks[7], (DEPTH, D_MIX, D_MODEL), D_MIX ** -0.5),
        "ffn_norm_g": 1.0 + nrm(ks[8], (DEPTH, D_MODEL), 0.1),
        "peer_w_query": nrm(ks[9], (DEPTH, D_MODEL, PEER_HEADS * PEER_KEY_DIM), D_MODEL ** -0.5),
        "peer_sub_keys": nrm(ks[10], (DEPTH, PEER_HEADS, 2, N_KEYS, PEER_HALF), PEER_HALF ** -0.5),
        "peer_u": nrm(ks[11], (DEPTH, N_EXPERTS, D_MODEL), D_MODEL ** -0.5),
        "peer_v": nrm(ks[12], (DEPTH, N_EXPERTS, D_MODEL), (PEER_HEADS) ** -0.5),
    }


def reference(x, attn_norm_g, w_in, q_norm_g, k_norm_g, pool_w, pool_scale, w_out,
              ffn_norm_g, peer_w_query, peer_sub_keys, peer_u, peer_v):
    B, S, D = x.shape
    pos = jnp.arange(S, dtype=jnp.float32)
    for l in range(DEPTH):
        h = _rmsnorm(x, attn_norm_g[l])
        proj = h @ w_in[l]
        q, k, v, p = jnp.split(proj, [D_ATT, 2 * D_ATT, 3 * D_ATT], axis=-1)
        q = _rope(_rmsnorm(q.reshape(B, S, N_ATT_HEADS, HEAD_DIM), q_norm_g[l]), pos)
        k = _rope(_rmsnorm(k.reshape(B, S, N_ATT_HEADS, HEAD_DIM), k_norm_g[l]), pos)
        v = v.astype(jnp.float32).reshape(B, S, N_ATT_HEADS, HEAD_DIM)
        att = _dilated_attention(q.transpose(0, 2, 1, 3), k.transpose(0, 2, 1, 3),
                                 v.transpose(0, 2, 1, 3))
        att = att.transpose(0, 2, 1, 3).reshape(B, S, D_ATT)
        pool = _pool_mixer(p, pool_w[l], pool_scale[l])
        mixed = jnp.concatenate([att, pool], axis=-1).astype(x.dtype)
        x = x + (mixed @ w_out[l]).astype(x.dtype)
        h2 = _rmsnorm(x, ffn_norm_g[l])
        x = x + _peer(h2, peer_w_query[l], peer_sub_keys[l], peer_u[l], peer_v[l]).astype(x.dtype)
    return x
```

```cpp
#include <hip/hip_runtime.h>
#include <stdint.h>
#include <math.h>
#include <cstdio>

namespace cfg {
constexpr int B = 4, S = 8192, D = 1024, T = B * S;
constexpr float EPS = 1e-6f;
constexpr float QSCALE = 0.125f * 1.4426950408889634f;
}
using namespace cfg;
typedef uint16_t bf16_t;
__device__ __forceinline__ uint32_t f2bf(float f) { uint32_t u = __float_as_uint(f); return (u + 0x7fffu + ((u >> 16) & 1u)) >> 16; }
__device__ __forceinline__ float bf2f(uint32_t h) { return __uint_as_float(h << 16); }
__device__ __forceinline__ float wave_sum(float v) {
#pragma unroll
    for (int o = 1; o < 64; o <<= 1) v += __shfl_xor(v, o);
    return v;
}

constexpr size_t MiB = 1u << 20;
constexpr size_t WS_CTL = 0;
constexpr size_t WS_RS1 = 1 * MiB;
constexpr size_t WS_SS2 = 2 * MiB;
constexpr size_t WS_WIN = 4 * MiB, WS_WOUT = 8 * MiB, WS_WSC = 10 * MiB, WS_POOLW = 14 * MiB;
constexpr size_t WS_ROPE = 15 * MiB;
constexpr size_t WS_XB = 20 * MiB;
constexpr size_t WS_Q = 84 * MiB, WS_K = 116 * MiB, WS_V = 148 * MiB, WS_P = 180 * MiB;
constexpr size_t WS_MIX = 212 * MiB;
constexpr size_t WS_XB2 = 276 * MiB;
constexpr size_t WS_U16 = 340 * MiB, WS_V16 = 372 * MiB;
constexpr size_t WS_IDX = 404 * MiB, WS_GATE = 420 * MiB;
constexpr size_t WS_STOP = 436 * MiB, WS_ITOP = 468 * MiB;
constexpr size_t WS_WPF = 500 * MiB;
constexpr size_t WS_END = 508 * MiB;

__global__ __launch_bounds__(256) void n_rope_table(float2* rope) {
    const int e = blockIdx.x * 256 + threadIdx.x;
    const int pos = e >> 5, j = e & 31;
    const double f = pow(10000.0, -(double)(2 * j) / 64.0);
    const double ang = (double)pos * f;
    rope[e] = make_float2((float)cos(ang), (float)sin(ang));
}

__global__ __launch_bounds__(256) void n_cvt_x(const float* __restrict__ x, bf16_t* __restrict__ xb, float* __restrict__ rs1) {
    const int row = (blockIdx.x * 256 + threadIdx.x) >> 6, lane = threadIdx.x & 63;
    const float4* xr = (const float4*)(x + (size_t)row * D);
    float4 v[4]; float ss = 0.f;
#pragma unroll
    for (int j = 0; j < 4; ++j) { v[j] = xr[lane + 64 * j]; ss += v[j].x * v[j].x + v[j].y * v[j].y + v[j].z * v[j].z + v[j].w * v[j].w; }
    ss = wave_sum(ss);
    if (lane == 0) rs1[row] = 1.0f / sqrtf(ss * (1.0f / D) + EPS);
    uint2* o = (uint2*)(xb + (size_t)row * D);
#pragma unroll
    for (int j = 0; j < 4; ++j) o[lane + 64 * j] = make_uint2(f2bf(v[j].x) | (f2bf(v[j].y) << 16), f2bf(v[j].z) | (f2bf(v[j].w) << 16));
}

template <int TN>
__device__ __forceinline__ void tile_gemm16(const bf16_t* __restrict__ A, int row0, int K, const float* __restrict__ W, int ldw, int col0,
                                            const float* __restrict__ gk, float (&acc)[TN / 16], float* As, float* Ws) {
    const int tid = threadIdx.x, ty = tid >> 4, tx = tid & 15;
    for (int k0 = 0; k0 < K; k0 += 32) {
#pragma unroll
        for (int i = 0; i < 2; ++i) { const int e = tid + 256 * i, r = e >> 5, c = e & 31; float a = bf2f(A[(size_t)(row0 + r) * K + k0 + c]); if (gk) a *= gk[k0 + c]; As[r * 33 + c] = a; }
#pragma unroll
        for (int i = 0; i < TN / 8; ++i) { const int e = tid + 256 * i, r = e / TN, c = e % TN; Ws[r * TN + c] = W[(size_t)(k0 + r) * ldw + col0 + c]; }
        __syncthreads();
#pragma unroll 8
        for (int kk = 0; kk < 32; ++kk) { const float a = As[ty * 33 + kk];
#pragma unroll
            for (int i = 0; i < TN / 16; ++i) acc[i] += a * Ws[kk * TN + tx + 16 * i]; }
        __syncthreads();
    }
}

__global__ __launch_bounds__(256) void n_proj(const bf16_t* __restrict__ xb, const float* __restrict__ rs1, const float* __restrict__ w_in, const float* __restrict__ g1,
                                              const float* __restrict__ qg, const float* __restrict__ kg, const float2* __restrict__ rope,
                                              bf16_t* __restrict__ Q, bf16_t* __restrict__ Kb, bf16_t* __restrict__ V, bf16_t* __restrict__ P) {
    __shared__ float As[16 * 33], Ws[32 * 64], Cs[16 * 65];
    const int row0 = blockIdx.x * 16, cb = blockIdx.y, col0 = cb * 64, tid = threadIdx.x, ty = tid >> 4, tx = tid & 15;
    float acc[4] = {0.f, 0.f, 0.f, 0.f};
    tile_gemm16<64>(xb, row0, D, w_in, 2048, col0, g1, acc, As, Ws);
    const float rs = rs1[row0 + ty];
#pragma unroll
    for (int i = 0; i < 4; ++i) Cs[ty * 65 + tx + 16 * i] = acc[i] * rs;
    __syncthreads();
    const int sec = cb >> 3, h = cb & 7; const size_t t = row0 + ty;
    if (sec < 2) {
        float ss = 0.f;
        for (int d = 0; d < 64; ++d) { const float c = Cs[ty * 65 + d]; ss += c * c; }
        const float rr = 1.0f / sqrtf(ss * (1.0f / 64.0f) + EPS);
        const float* g = sec == 0 ? qg : kg; bf16_t* dst = sec == 0 ? Q : Kb;
        const int pos = (int)(t % S);
#pragma unroll
        for (int jj = 0; jj < 2; ++jj) { const int j = tx + 16 * jj;
            const float y1 = Cs[ty * 65 + j] * rr * g[j], y2 = Cs[ty * 65 + j + 32] * rr * g[j + 32]; const float2 cs = rope[pos * 32 + j];
            float o1 = y1 * cs.x - y2 * cs.y, o2 = y2 * cs.x + y1 * cs.y; if (sec == 0) { o1 *= QSCALE; o2 *= QSCALE; }
            dst[t * 512 + h * 64 + j] = (bf16_t)f2bf(o1); dst[t * 512 + h * 64 + j + 32] = (bf16_t)f2bf(o2); }
    } else {
        bf16_t* dst = sec == 2 ? V : P;
#pragma unroll
        for (int i = 0; i < 4; ++i) dst[t * 512 + h * 64 + tx + 16 * i] = (bf16_t)f2bf(Cs[ty * 65 + tx + 16 * i]);
    }
}

__global__ __launch_bounds__(256) void n_attn(const bf16_t* __restrict__ Q, const bf16_t* __restrict__ Kb, const bf16_t* __restrict__ V, bf16_t* __restrict__ mix) {
    const int w = (blockIdx.x * 256 + threadIdx.x) >> 6, lane = threadIdx.x & 63;
    const int h = w & 7, t = w >> 3, b = t / S, pos = t % S;
    const float q = bf2f(Q[(size_t)t * 512 + h * 64 + lane]);
    float m = -INFINITY, l = 0.f, o = 0.f;
    for (int br = 0; br < 3; ++br) { const int dil = br == 0 ? 1 : (br == 1 ? 4 : 16);
        for (int j = 0; j <= 128; ++j) { const int kp = pos - j * dil; if (kp < 0) break;
            const size_t r = (size_t)(b * S + kp) * 512 + h * 64 + lane;
            const float s = wave_sum(q * bf2f(Kb[r])); const float mn = fmaxf(m, s); const float sc = exp2f(m - mn), p = exp2f(s - mn);
            l = l * sc + p; o = o * sc + p * bf2f(V[r]); m = mn; } }
    mix[(size_t)t * 1024 + h * 64 + lane] = (bf16_t)f2bf(o / l);
}

__global__ __launch_bounds__(256) void n_pool(const bf16_t* __restrict__ P, const float* __restrict__ pool_w, const float* __restrict__ pool_scale, bf16_t* __restrict__ mix) {
    __shared__ float Pl[16 * 129];
    const int row0 = blockIdx.x * 16, g = blockIdx.y, w = 2 << g, tid = threadIdx.x, ty = tid >> 4, tx = tid & 15;
#pragma unroll
    for (int i = 0; i < 8; ++i) { const int e = tid + 256 * i, r = e >> 7, c = e & 127; const int t = row0 + r, pos = t % S; const int cnt = (pos + 1) < w ? (pos + 1) : w;
        float sum = 0.f; for (int s = 0; s < cnt; ++s) sum += bf2f(P[(size_t)(t - s) * 512 + g * 128 + c]);
        Pl[r * 129 + c] = sum / (float)cnt - bf2f(P[(size_t)t * 512 + g * 128 + c]); }
    __syncthreads();
    float acc[8] = {0.f, 0.f, 0.f, 0.f, 0.f, 0.f, 0.f, 0.f};
    for (int c = 0; c < 128; ++c) { const float a = Pl[ty * 129 + c];
#pragma unroll
        for (int i = 0; i < 8; ++i) acc[i] += a * pool_w[(size_t)(g * 128 + c) * 128 + tx + 16 * i]; }
#pragma unroll
    for (int i = 0; i < 8; ++i) { const int d = tx + 16 * i; mix[(size_t)(row0 + ty) * 1024 + 512 + g * 128 + d] = (bf16_t)f2bf(acc[i] * pool_scale[g * 128 + d]); }
}

__global__ __launch_bounds__(256) void n_oproj(const bf16_t* __restrict__ mix, const float* __restrict__ w_out, const float* __restrict__ x, float* __restrict__ out,
                                               bf16_t* __restrict__ xb2, float* __restrict__ ss2) {
    __shared__ float As[16 * 33], Ws[32 * 64], Cs[16 * 65];
    const int row0 = blockIdx.x * 16, cb = blockIdx.y, col0 = cb * 64, tid = threadIdx.x, ty = tid >> 4, tx = tid & 15;
    float acc[4] = {0.f, 0.f, 0.f, 0.f};
    tile_gemm16<64>(mix, row0, D, w_out, 1024, col0, nullptr, acc, As, Ws);
    const size_t t = row0 + ty;
#pragma unroll
    for (int i = 0; i < 4; ++i) { const int c = col0 + tx + 16 * i; const float x2 = x[t * D + c] + acc[i]; out[t * D + c] = x2; xb2[t * D + c] = (bf16_t)f2bf(x2); Cs[ty * 65 + tx + 16 * i] = x2 * x2; }
    __syncthreads();
    if (tx == 0) { float s = 0.f; for (int d = 0; d < 64; ++d) s += Cs[ty * 65 + d]; ss2[t * 16 + cb] = s; }
}

__global__ __launch_bounds__(256) void n_wprime(const float* __restrict__ wq, const float* __restrict__ sk, const float* __restrict__ g2, float* __restrict__ wpf) {
    const int e = blockIdx.x * 256 + threadIdx.x;
    const int k = e >> 11, col = e & 2047, hp = col >> 7, n = col & 127;
    const float* a = wq + (size_t)k * 2048 + hp * 128; const float* b = sk + ((size_t)hp * 128 + n) * 128;
    float s = 0.f; for (int c = 0; c < 128; ++c) s += a[c] * b[c];
    wpf[e] = s * g2[k];
}

__device__ __forceinline__ float rstd2_of(const float* ss2, size_t t) { float s = 0.f;
#pragma unroll
    for (int i = 0; i < 16; ++i) s += ss2[t * 16 + i];
    return 1.0f / sqrtf(s * (1.0f / D) + EPS); }

__global__ __launch_bounds__(256) void n_scores(const bf16_t* __restrict__ xb2, const float* __restrict__ ss2, const float* __restrict__ wpf, float* __restrict__ stop, int* __restrict__ itop) {
    __shared__ float As[16 * 33], Ws[32 * 128], Cs[16 * 129];
    const int row0 = blockIdx.x * 16, hp = blockIdx.y, col0 = hp * 128, tid = threadIdx.x, ty = tid >> 4, tx = tid & 15;
    float acc[8] = {0.f, 0.f, 0.f, 0.f, 0.f, 0.f, 0.f, 0.f};
    tile_gemm16<128>(xb2, row0, D, wpf, 2048, col0, nullptr, acc, As, Ws);
    const float rs = rstd2_of(ss2, row0 + ty);
#pragma unroll
    for (int i = 0; i < 8; ++i) Cs[ty * 129 + tx + 16 * i] = acc[i] * rs;
    __syncthreads();
    if (tid < 16) { const size_t t = row0 + tid;
        for (int r = 0; r < 16; ++r) { float bv = -INFINITY; int bi = 0;
            for (int n = 0; n < 128; ++n) { const float v = Cs[tid * 129 + n]; if (v > bv) { bv = v; bi = n; } }
            Cs[tid * 129 + bi] = -INFINITY; stop[(t * 16 + hp) * 16 + r] = bv; itop[(t * 16 + hp) * 16 + r] = bi; } }
}

__global__ __launch_bounds__(256) void n_combine(const float* __restrict__ stop, const int* __restrict__ itop, int* __restrict__ idx, float* __restrict__ gate) {
    const int w = (blockIdx.x * 256 + threadIdx.x) >> 6, lane = threadIdx.x & 63;
    const int h = w & 7; const size_t t = w >> 3;
    const float* sa = stop + (t * 16 + h * 2) * 16; const float* sb = sa + 16; const int* ia = itop + (t * 16 + h * 2) * 16; const int* ib = ia + 16;
    float v0, v1, v2, v3;
    { const int c0 = lane, c1 = lane + 64, c2 = lane + 128, c3 = lane + 192;
      v0 = sa[c0 >> 4] + sb[c0 & 15]; v1 = sa[c1 >> 4] + sb[c1 & 15]; v2 = sa[c2 >> 4] + sb[c2 & 15]; v3 = sa[c3 >> 4] + sb[c3 & 15]; }
    float myv = -INFINITY; int myc = 0;
    for (int r = 0; r < 16; ++r) {
        float bv = v0; int bc = lane;
        if (v1 > bv) { bv = v1; bc = lane + 64; } if (v2 > bv) { bv = v2; bc = lane + 128; } if (v3 > bv) { bv = v3; bc = lane + 192; }
#pragma unroll
        for (int off = 32; off >= 1; off >>= 1) { const float ov = __shfl_xor(bv, off); const int oc = __shfl_xor(bc, off); if (ov > bv || (ov == bv && oc < bc)) { bv = ov; bc = oc; } }
        if (bc == lane) v0 = -INFINITY; if (bc == lane + 64) v1 = -INFINITY; if (bc == lane + 128) v2 = -INFINITY; if (bc == lane + 192) v3 = -INFINITY;
        if (lane == r) { myv = bv; myc = bc; }
    }
    const float mx = __shfl(myv, 0);
    const float e = lane < 16 ? expf(myv - mx) : 0.f;
    const float sum = wave_sum(e);
    if (lane < 16) { idx[t * 128 + h * 16 + lane] = ia[myc >> 4] * 128 + ib[myc & 15]; gate[t * 128 + h * 16 + lane] = e / sum; }
}

__global__ __launch_bounds__(256) void n_expert(float* __restrict__ out, const float* __restrict__ ss2, const float* __restrict__ g2, const int* __restrict__ idx, const float* __restrict__ gate,
                                                const float* __restrict__ pu, const float* __restrict__ pv) {
    __shared__ float h2[1024]; __shared__ float red[4];
    const size_t t = blockIdx.x; const int tid = threadIdx.x, lane = tid & 63, wv = tid >> 6;
    const float rs = rstd2_of(ss2, t);
    float xv[4], y[4];
#pragma unroll
    for (int i = 0; i < 4; ++i) { const int d = tid + 256 * i; xv[i] = out[t * D + d]; h2[d] = xv[i] * rs * g2[d]; y[i] = 0.f; }
    __syncthreads();
    for (int k = 0; k < 128; ++k) { const size_t e = (size_t)idx[t * 128 + k]; const float gt = gate[t * 128 + k];
        float part = 0.f;
#pragma unroll
        for (int i = 0; i < 4; ++i) part += pu[e * D + tid + 256 * i] * h2[tid + 256 * i];
        part = wave_sum(part); if (lane == 0) red[wv] = part;
        __syncthreads();
        const float a = (red[0] + red[1]) + (red[2] + red[3]);
        const float act = 0.5f * a * (1.0f + erff(a * 0.70710678118654752f)) * gt;
#pragma unroll
        for (int i = 0; i < 4; ++i) y[i] += act * pv[e * D + tid + 256 * i];
        __syncthreads();
    }
#pragma unroll
    for (int i = 0; i < 4; ++i) out[t * D + tid + 256 * i] = xv[i] + y[i];
}

extern "C" void kernel_launch(void* const* d_in, const int* in_sizes, int n_in, void* d_out, int out_size, void* d_ws, size_t ws_size, hipStream_t stream) {
    if (n_in != 13 || in_sizes[0] != T * D || out_size != T * D || ws_size < WS_END) { fprintf(stderr, "kernel_launch: unexpected shapes (n_in %d, in0 %d, out %d, ws %zu)\n", n_in, n_in > 0 ? in_sizes[0] : -1, out_size, ws_size); return; }
    const float* x = (const float*)d_in[0]; const float* g1 = (const float*)d_in[1]; const float* w_in = (const float*)d_in[2];
    const float* qg = (const float*)d_in[3]; const float* kg = (const float*)d_in[4]; const float* pool_w = (const float*)d_in[5]; const float* pool_scale = (const float*)d_in[6];
    const float* w_out = (const float*)d_in[7]; const float* g2 = (const float*)d_in[8]; const float* wq = (const float*)d_in[9]; const float* sk = (const float*)d_in[10];
    const float* pu = (const float*)d_in[11]; const float* pv = (const float*)d_in[12];
    unsigned char* ws = (unsigned char*)d_ws; float* out = (float*)d_out;
    float* rs1 = (float*)(ws + WS_RS1); float* ss2 = (float*)(ws + WS_SS2); float2* rope = (float2*)(ws + WS_ROPE);
    bf16_t* xb = (bf16_t*)(ws + WS_XB); bf16_t* Q = (bf16_t*)(ws + WS_Q); bf16_t* Kb = (bf16_t*)(ws + WS_K); bf16_t* V = (bf16_t*)(ws + WS_V); bf16_t* P = (bf16_t*)(ws + WS_P);
    bf16_t* mix = (bf16_t*)(ws + WS_MIX); bf16_t* xb2 = (bf16_t*)(ws + WS_XB2);
    int* idx = (int*)(ws + WS_IDX); float* gate = (float*)(ws + WS_GATE); float* stop = (float*)(ws + WS_STOP); int* itop = (int*)(ws + WS_ITOP); float* wpf = (float*)(ws + WS_WPF);

    n_rope_table<<<S * 32 / 256, 256, 0, stream>>>(rope);
    n_cvt_x<<<T / 4, 256, 0, stream>>>(x, xb, rs1);
    n_wprime<<<1024 * 2048 / 256, 256, 0, stream>>>(wq, sk, g2, wpf);
    n_proj<<<dim3(T / 16, 32), 256, 0, stream>>>(xb, rs1, w_in, g1, qg, kg, rope, Q, Kb, V, P);
    n_attn<<<T * 8 / 4, 256, 0, stream>>>(Q, Kb, V, mix);
    n_pool<<<dim3(T / 16, 4), 256, 0, stream>>>(P, pool_w, pool_scale, mix);
    n_oproj<<<dim3(T / 16, 16), 256, 0, stream>>>(mix, w_out, x, out, xb2, ss2);
    n_scores<<<dim3(T / 16, 16), 256, 0, stream>>>(xb2, ss2, wpf, stop, itop);
    n_combine<<<T * 8 / 4, 256, 0, stream>>>(stop, itop, idx, gate);
    n_expert<<<T, 256, 0, stream>>>(out, ss2, g2, idx, gate, pu, pv);
}
```

```cpp
#include <hip/hip_runtime.h>
#include <stdint.h>
#include <math.h>
#include <cstdio>

namespace cfg {
constexpr int B = 4, S = 8192, D = 1024, T = B * S;
constexpr float EPS = 1e-6f;
constexpr float QSCALE = 0.125f * 1.4426950408889634f;
}
using namespace cfg;
typedef uint16_t bf16_t;
__device__ __forceinline__ uint32_t f2bf(float f) { uint32_t u = __float_as_uint(f); return (u + 0x7fffu + ((u >> 16) & 1u)) >> 16; }
__device__ __forceinline__ float bf2f(uint32_t h) { return __uint_as_float(h << 16); }
__device__ __forceinline__ float wave_sum(float v) {
#pragma unroll
    for (int o = 1; o < 64; o <<= 1) v += __shfl_xor(v, o);
    return v;
}

constexpr size_t MiB = 1u << 20;
constexpr size_t WS_CTL = 0;
constexpr size_t WS_RS1 = 1 * MiB;
constexpr size_t WS_SS2 = 2 * MiB;
constexpr size_t WS_WIN = 4 * MiB, WS_WOUT = 8 * MiB, WS_WSC = 10 * MiB, WS_POOLW = 14 * MiB;
constexpr size_t WS_ROPE = 15 * MiB;
constexpr size_t WS_XB = 20 * MiB;
constexpr size_t WS_Q = 84 * MiB, WS_K = 116 * MiB, WS_V = 148 * MiB, WS_P = 180 * MiB;
constexpr size_t WS_MIX = 212 * MiB;
constexpr size_t WS_XB2 = 276 * MiB;
constexpr size_t WS_U16 = 340 * MiB, WS_V16 = 372 * MiB;
constexpr size_t WS_IDX = 404 * MiB, WS_GATE = 420 * MiB;
constexpr size_t WS_END = 436 * MiB;


namespace pg8 {
#define PG8_LAS __attribute__((address_space(3)))
typedef unsigned short bf16_t;
typedef short bf16x8 __attribute__((ext_vector_type(8)));
typedef float f32x4 __attribute__((ext_vector_type(4)));
typedef unsigned u32x4 __attribute__((ext_vector_type(4)));
constexpr int BM = 256, BK = 64, HALF = 128, HTB = HALF * BK * 2  , STAGE_BYTES = 8 * HTB, NXCD = 8, WGM = 8;

__host__ __device__ __forceinline__ int lds_byte(int r, int c) { const int st = (r >> 4) * 2 + (c >> 5), rr = r & 15, cc = c & 31, ob = rr * 64 + cc * 2; return st * 1024 + (ob ^ (((ob >> 9) & 1) << 5)); }
__host__ __device__ __forceinline__ void stage_rc(int b, int& R, int& C) { const int st = b / 1024, sb = b % 1024, swz = sb ^ (((sb >> 9) & 1) << 5); R = (st >> 1) * 16 + swz / 64; C = (st & 1) * 32 + (swz % 64) / 2; }
__host__ __device__ __forceinline__ int perm32(int rho) { const int n = rho >> 4, i = rho & 15; return 8 * (i >> 2) + 4 * n + (i & 3); }

struct Unit { int pm, pn; };
struct Gemm { const bf16_t* A; const bf16_t* Bt; int M, N, K; };

struct StaticOrder {
    int nM, nN, nwg, G, c;
    __host__ __device__ void init(int M, int N, int G_, int c_) { nM = M / BM; nN = N / BM; nwg = nM * nN; G = G_; c = c_; }
    __host__ __device__ bool next(int i, Unit& u) const {
        const long L = (long)i * G + c; if (L >= nwg) return false;
        int wgid = (int)L; { const int q = nwg / NXCD, r = nwg % NXCD, xcd = wgid % NXCD, off = wgid / NXCD; wgid = (xcd < r ? xcd * (q + 1) : r * (q + 1) + (xcd - r) * q) + off; }
        const int nig = WGM * nN, gid = wgid / nig, fm = gid * WGM, gsz = (nM - fm) < WGM ? (nM - fm) : WGM;
        u.pm = fm + ((wgid % nig) % gsz); u.pn = (wgid % nig) / gsz; return true;
    }
    __device__ __forceinline__ void a_ready(const Unit&) const {}
    __device__ __forceinline__ void done(const Unit&) const {}
};

__device__ __forceinline__ unsigned cvt_pk_bf16(float lo, float hi) { unsigned r; asm volatile("v_cvt_pk_bf16_f32 %0, %1, %2" : "=v"(r) : "v"(lo), "v"(hi)); return r; }
typedef float f32x2 __attribute__((ext_vector_type(2)));
__device__ __forceinline__ f32x2 gelu_pk(f32x2 v) {
    const f32x2 av = __builtin_elementwise_abs(v), d = av * 0.2316418882f + 1.0f;
    f32x2 t; t.x = __builtin_amdgcn_rcpf(d.x); t.y = __builtin_amdgcn_rcpf(d.y);
    f32x2 q = t * 0.5307027145f + (-0.7265760135f); q = q * t + 0.7107068705f; q = q * t + (-0.142248368f); q = q * t + 0.127414796f; q = q * t;
    const f32x2 s = (v * v) * (-0.72134752044f);
    f32x2 e; e.x = __builtin_amdgcn_exp2f(s.x); e.y = __builtin_amdgcn_exp2f(s.y);
    const f32x2 m = v * (q * e), r = v - m;
    f32x2 o; o.x = v.x < 0.f ? m.x : r.x; o.y = v.y < 0.f ? m.y : r.y; return o;
}

template <int ACT  > struct EpiBf16 {
    static constexpr bool PERM = true, AFTER_DRAIN = false; static_assert(ACT == 0 || ACT == 1, "EpiBf16: ACT is 0 (none) or 1 (gelu_pk)");
    bf16_t* O; int ldc; const float* bias; int split_cols; size_t split_stride; float scale0;
    __device__ __forceinline__ void operator()(const f32x4 (&acc)[2][2][4][2], const Unit& u, int wr, int wc, int fr, int fq) const {
        const int row0 = u.pm * BM + wr * 64 + fr; int colt = u.pn * BM; bf16_t* base = O;
        float sc = 1.f; if (split_cols) { const int t = colt / split_cols; base += (size_t)t * split_stride; colt -= t * split_cols; if (t == 0) sc = scale0; }
        const int col0 = colt + wc * 32 + 8 * fq, bcol0 = u.pn * BM + wc * 32 + 8 * fq;
        f32x4 bv[2][2];
#pragma unroll
        for (int bj = 0; bj < 2; ++bj)
#pragma unroll
            for (int n = 0; n < 2; ++n) bv[bj][n] = bias ? *(const f32x4*)(bias + bcol0 + bj * HALF + 4 * n) : (f32x4){0.f, 0.f, 0.f, 0.f};
#pragma unroll
        for (int ai = 0; ai < 2; ++ai)
#pragma unroll
            for (int m = 0; m < 4; ++m) { bf16_t* rowp = base + (size_t)(row0 + ai * HALF + m * 16) * ldc + col0;
#pragma unroll
                for (int bj = 0; bj < 2; ++bj) { f32x4 v0 = acc[ai][bj][m][0] + bv[bj][0], v1 = acc[ai][bj][m][1] + bv[bj][1];
                    if (ACT == 1) { f32x2 a = gelu_pk((f32x2){v0[0], v0[1]}), b = gelu_pk((f32x2){v0[2], v0[3]}), c = gelu_pk((f32x2){v1[0], v1[1]}), d = gelu_pk((f32x2){v1[2], v1[3]});
                        v0 = (f32x4){a.x, a.y, b.x, b.y}; v1 = (f32x4){c.x, c.y, d.x, d.y}; }
                    v0 = v0 * sc; v1 = v1 * sc; u32x4 w; w.x = cvt_pk_bf16(v0[0], v0[1]); w.y = cvt_pk_bf16(v0[2], v0[3]); w.z = cvt_pk_bf16(v1[0], v1[1]); w.w = cvt_pk_bf16(v1[2], v1[3]);
                    *(u32x4*)(rowp + bj * HALF) = w; } }
    }
};

template <class Epi, class Sched, bool ALIGN_EPI = false, bool SP2 = false>
__device__ __forceinline__ void gemm_phase(PG8_LAS unsigned char* lds, const Gemm g, const Sched& S, const Epi& E, int tid_in) {
    int tid_ = tid_in; asm volatile("" : "+v"(tid_));
    const int tid = tid_, wid = __builtin_amdgcn_readfirstlane(tid >> 6), lane = tid & 63, wr = wid >> 2, wc = wid & 3, fr = lane & 15, fq = lane >> 4;
    const int K = g.K, nt = K / BK;
    unsigned voffA[2], voffB[2];
#pragma unroll
    for (int i = 0; i < 2; ++i) { int R, C; stage_rc(tid * 16 + i * 8192, R, C); const int Rb = Epi::PERM ? ((R & ~31) + perm32(R & 31)) : R;
        voffA[i] = (unsigned)(R * K + C) * 2u; voffB[i] = (unsigned)(Rb * K + C) * 2u; }
    const size_t kstep = (size_t)(BK * 2);
    const size_t hstep = (size_t)HALF * K * 2;
    const size_t tstep = 2 * hstep;
    const unsigned ldsw = (unsigned)wid * 1024u;
    const int aoff = lds_byte(wr * 64 + fr, fq * 8), boff = lds_byte(wc * 32 + fr, fq * 8);
#define PG8_SA(b, h) (((b) * 2 + (h)) * HTB)
#define PG8_SB(b, h) ((4 + (b) * 2 + (h)) * HTB)
#define PG8_STAGE(bufoff, gbase, voff) do { _Pragma("unroll") for (int _i = 0; _i < 2; ++_i) \
        __builtin_amdgcn_global_load_lds((const unsigned*)((const char*)(gbase) + (voff)[_i]), (PG8_LAS unsigned*)(lds + (bufoff) + ldsw + _i * 8192), 16, 0, 0); } while (0)
#define PG8_LDA(dst, b, h) do { _Pragma("unroll") for (int m = 0; m < 4; ++m) _Pragma("unroll") for (int k = 0; k < 2; ++k) dst[m][k] = *(const PG8_LAS bf16x8*)(lds + PG8_SA(b, h) + aoff + m * 2048 + k * 1024); } while (0)
#define PG8_LDB(dst, b, h) do { _Pragma("unroll") for (int n = 0; n < 2; ++n) _Pragma("unroll") for (int k = 0; k < 2; ++k) dst[n][k] = *(const PG8_LAS bf16x8*)(lds + PG8_SB(b, h) + boff + n * 2048 + k * 1024); } while (0)
#define PG8_MMA(ai, bj, At, Bt) do { __builtin_amdgcn_s_setprio(1); _Pragma("unroll") for (int m = 0; m < 4; ++m) _Pragma("unroll") for (int n = 0; n < 2; ++n) _Pragma("unroll") for (int k = 0; k < 2; ++k) \
        acc[ai][bj][m][n] = __builtin_amdgcn_mfma_f32_16x16x32_bf16(Bt[n][k], At[m][k], acc[ai][bj][m][n], 0, 0, 0); __builtin_amdgcn_s_setprio(0); } while (0)
#define PG8_WAIT_V(n) asm volatile("s_waitcnt vmcnt(" #n ")" ::: "memory")
#define PG8_WAIT_L(n) asm volatile("s_waitcnt lgkmcnt(" #n ")" ::: "memory")
#define PG8_BAR __builtin_amdgcn_s_barrier()
#define PG8_SCHED __builtin_amdgcn_sched_barrier(0)
    Unit cur, nxt; int ui = 0;
    if (!S.next(0, cur)) return;
    f32x4 acc[2][2][4][2];
#pragma unroll
    for (int a = 0; a < 2; ++a)
#pragma unroll
        for (int b = 0; b < 2; ++b)
#pragma unroll
            for (int m = 0; m < 4; ++m)
#pragma unroll
                for (int n = 0; n < 2; ++n) acc[a][b][m][n] = (f32x4){0.f, 0.f, 0.f, 0.f};
    bf16x8 At[4][2], B0[2][2], B1[2][2];
    const char* cA = (const char*)g.A + (size_t)cur.pm * tstep; const char* cB = (const char*)g.Bt + (size_t)cur.pn * tstep;
    S.a_ready(cur);
    if constexpr (SP2) {
        PG8_STAGE(PG8_SB(0, 0), cB, voffB); PG8_STAGE(PG8_SB(0, 1), cB + hstep, voffB); PG8_STAGE(PG8_SA(0, 0), cA, voffA); PG8_STAGE(PG8_SA(0, 1), cA + hstep, voffA);
        if (wr == 1) PG8_BAR;
        PG8_WAIT_V(2); PG8_BAR;
        PG8_STAGE(PG8_SB(1, 0), cB + kstep, voffB); PG8_STAGE(PG8_SA(1, 0), cA + kstep, voffA); PG8_STAGE(PG8_SB(1, 1), cB + hstep + kstep, voffB);
        PG8_WAIT_V(6); PG8_BAR;
    } else {
        PG8_STAGE(PG8_SB(0, 0), cB, voffB); PG8_STAGE(PG8_SA(0, 0), cA, voffA); PG8_STAGE(PG8_SB(0, 1), cB + hstep, voffB); PG8_STAGE(PG8_SA(0, 1), cA + hstep, voffA);
        if (wr == 1) PG8_BAR;
        PG8_WAIT_V(4); PG8_BAR;
        PG8_STAGE(PG8_SB(1, 0), cB + kstep, voffB); PG8_STAGE(PG8_SA(1, 0), cA + kstep, voffA); PG8_STAGE(PG8_SB(1, 1), cB + hstep + kstep, voffB);
        PG8_WAIT_V(6); PG8_BAR;
    }
    for (;;) {
        const bool has_next = S.next(ui + 1, nxt);
        const char* nA = has_next ? (const char*)g.A + (size_t)nxt.pm * tstep : cA; const char* nB = has_next ? (const char*)g.Bt + (size_t)nxt.pn * tstep : cB;
        for (int t = 0; t < nt; t += 2) {
            const bool last = (t == nt - 2);
            const char* a1 = cA + (size_t)(t + 1) * kstep;
            const char* a2 = last ? nA : cA + (size_t)(t + 2) * kstep; const char* b2 = last ? nB : cB + (size_t)(t + 2) * kstep;
            const char* a3 = a2 + kstep; const char* b3 = b2 + kstep;
            if (last && has_next) S.a_ready(nxt);
            if constexpr (SP2) {
            PG8_LDB(B0, 0, 0); PG8_LDB(B1, 0, 1); PG8_SCHED; PG8_LDA(At, 0, 0); PG8_STAGE(PG8_SA(1, 1), a1 + hstep, voffA);
            PG8_WAIT_V(8); PG8_WAIT_L(0); PG8_BAR; PG8_MMA(0, 0, At, B0); PG8_MMA(0, 1, At, B1); PG8_BAR; PG8_SCHED;
            PG8_LDA(At, 0, 1); PG8_STAGE(PG8_SB(0, 0), b2, voffB); PG8_STAGE(PG8_SB(0, 1), b2 + hstep, voffB); PG8_STAGE(PG8_SA(0, 0), a2, voffA);
            PG8_WAIT_V(8); PG8_WAIT_L(0); PG8_BAR; PG8_MMA(1, 0, At, B0); PG8_MMA(1, 1, At, B1); PG8_BAR; PG8_SCHED;
            PG8_LDB(B0, 1, 0); PG8_LDB(B1, 1, 1); PG8_SCHED; PG8_LDA(At, 1, 0); PG8_STAGE(PG8_SA(0, 1), a2 + hstep, voffA);
            PG8_WAIT_V(8); PG8_WAIT_L(0); PG8_BAR; PG8_MMA(0, 0, At, B0); PG8_MMA(0, 1, At, B1); PG8_BAR; PG8_SCHED;
            PG8_LDA(At, 1, 1); PG8_STAGE(PG8_SB(1, 0), b3, voffB); PG8_STAGE(PG8_SB(1, 1), b3 + hstep, voffB); PG8_STAGE(PG8_SA(1, 0), a3, voffA);
            PG8_WAIT_V(8); PG8_WAIT_L(0); PG8_BAR; PG8_MMA(1, 0, At, B0); PG8_MMA(1, 1, At, B1); PG8_BAR; PG8_SCHED;
            } else {
            PG8_LDB(B0, 0, 0); PG8_SCHED; PG8_LDA(At, 0, 0); PG8_STAGE(PG8_SA(1, 1), a1 + hstep, voffA);
            PG8_WAIT_L(8); PG8_BAR; PG8_WAIT_L(0); PG8_MMA(0, 0, At, B0); PG8_BAR; PG8_SCHED;
            PG8_LDB(B1, 0, 1); PG8_STAGE(PG8_SB(0, 0), b2, voffB);
            PG8_BAR; PG8_WAIT_L(0); PG8_MMA(0, 1, At, B1); PG8_BAR;
            PG8_LDA(At, 0, 1); PG8_STAGE(PG8_SA(0, 0), a2, voffA);
            PG8_BAR; PG8_WAIT_L(0); PG8_MMA(1, 0, At, B0); PG8_BAR; PG8_SCHED;
            PG8_STAGE(PG8_SB(0, 1), b2 + hstep, voffB);
            PG8_WAIT_V(6); PG8_BAR; PG8_MMA(1, 1, At, B1); PG8_BAR;
            PG8_LDB(B0, 1, 0); PG8_SCHED; PG8_LDA(At, 1, 0); PG8_STAGE(PG8_SA(0, 1), a2 + hstep, voffA);
            PG8_WAIT_L(8); PG8_BAR; PG8_WAIT_L(0); PG8_MMA(0, 0, At, B0); PG8_BAR; PG8_SCHED;
            PG8_LDB(B1, 1, 1); PG8_STAGE(PG8_SB(1, 0), b3, voffB);
            PG8_BAR; PG8_WAIT_L(0); PG8_MMA(0, 1, At, B1); PG8_BAR;
            PG8_LDA(At, 1, 1); PG8_STAGE(PG8_SA(1, 0), a3, voffA);
            PG8_BAR; PG8_WAIT_L(0); PG8_MMA(1, 0, At, B0); PG8_BAR; PG8_SCHED;
            PG8_STAGE(PG8_SB(1, 1), b3 + hstep, voffB);
            PG8_WAIT_V(6); PG8_BAR; PG8_MMA(1, 1, At, B1); PG8_BAR;
            }
        }
        if constexpr (ALIGN_EPI) { if (wr == 0) PG8_BAR; }
        if constexpr (!Epi::AFTER_DRAIN) { E(acc, cur, wr, wc, fr, fq); S.done(cur); }
        if (!has_next) break;
#pragma unroll
        for (int a = 0; a < 2; ++a)
#pragma unroll
            for (int b = 0; b < 2; ++b)
#pragma unroll
                for (int m = 0; m < 4; ++m)
#pragma unroll
                    for (int n = 0; n < 2; ++n) acc[a][b][m][n] = (f32x4){0.f, 0.f, 0.f, 0.f};
        cur = nxt; cA = nA; cB = nB; ++ui;
        if constexpr (ALIGN_EPI) { if (wr == 1) PG8_BAR; }
    }
    PG8_WAIT_V(0);
    if constexpr (!ALIGN_EPI) { if (wr == 0) PG8_BAR; }
    PG8_BAR;
    if constexpr (Epi::AFTER_DRAIN) { E.fused(acc, cur, wr, wc, fr, fq, lds, wid, lane); S.done(cur); }
#undef PG8_SA
#undef PG8_SB
#undef PG8_STAGE
#undef PG8_LDA
#undef PG8_LDB
#undef PG8_MMA
#undef PG8_WAIT_V
#undef PG8_WAIT_L
#undef PG8_BAR
#undef PG8_SCHED
}
}

constexpr int NTHREADS = 512, NWAVES = 8;
constexpr int LDS_BYTES = 147456;
struct Args { const float* in[13]; float* out; unsigned char* ws; };
constexpr int CW_BAR = 4096;
constexpr size_t CTL_ZERO_BYTES = 65536;
constexpr int MISC_OFF = 131072 + 8192;


#define LAS __attribute__((address_space(3)))
typedef unsigned u32x4 __attribute__((ext_vector_type(4)));
typedef unsigned u32x2 __attribute__((ext_vector_type(2)));
typedef float f32x4 __attribute__((ext_vector_type(4)));
typedef __bf16 bf16x2_t __attribute__((ext_vector_type(2)));
typedef float f32x2_cv __attribute__((ext_vector_type(2)));
__device__ __forceinline__ unsigned pk2(float lo, float hi) { const f32x2_cv v = {lo, hi}; return __builtin_bit_cast(unsigned, __builtin_convertvector(v, bf16x2_t)); }

struct EpiProj {
    static constexpr bool PERM = true, AFTER_DRAIN = false;
    const float* rs1; const float* qg; const float* kg; const float2* rope; bf16_t* Q; bf16_t* Kb; bf16_t* V; bf16_t* P;
    __device__ __forceinline__ void operator()(const f32x4 (&acc)[2][2][4][2], const pg8::Unit& u, int wr, int wc, int fr, int fq) const {
        const int pn = u.pn;
        if (pn < 4) {
            const int head = 4 * (pn & 1) + wc; const bool isq = pn < 2; const float* g = isq ? qg : kg; bf16_t* dst = isq ? Q : Kb; const float osc = isq ? QSCALE : 1.0f;
            f32x4 gv[2][2];
#pragma unroll
            for (int bj = 0; bj < 2; ++bj)
#pragma unroll
                for (int n = 0; n < 2; ++n) gv[bj][n] = *(const f32x4*)(g + 32 * bj + 8 * fq + 4 * n);
#pragma unroll
            for (int ai = 0; ai < 2; ++ai)
#pragma unroll
                for (int m = 0; m < 4; ++m) {
                    const int row = u.pm * 256 + ai * 128 + wr * 64 + m * 16 + fr; const float rs = rs1[row]; const int pos = row & (S - 1);
                    f32x4 v[2][2]; float ss = 0.f;
#pragma unroll
                    for (int bj = 0; bj < 2; ++bj)
#pragma unroll
                        for (int n = 0; n < 2; ++n) { v[bj][n] = acc[ai][bj][m][n] * rs; const f32x4 t = v[bj][n]; ss += (t[0] * t[0] + t[1] * t[1]) + (t[2] * t[2] + t[3] * t[3]); }
                    ss += __shfl_xor(ss, 16); ss += __shfl_xor(ss, 32);
                    const float rr = 1.0f / sqrtf(ss * (1.0f / 64.0f) + EPS);
                    u32x4 w1, w2;
#pragma unroll
                    for (int n = 0; n < 2; ++n) {
                        const f32x4 csA = *(const f32x4*)((const float*)rope + (size_t)(pos * 32 + 8 * fq + 4 * n) * 2), csB = *(const f32x4*)((const float*)rope + (size_t)(pos * 32 + 8 * fq + 4 * n) * 2 + 4);
                        const f32x4 y1 = v[0][n] * rr * gv[0][n], y2 = v[1][n] * rr * gv[1][n];
                        const f32x4 c = {csA[0], csA[2], csB[0], csB[2]}, s = {csA[1], csA[3], csB[1], csB[3]};
                        const f32x4 o1 = (y1 * c - y2 * s) * osc, o2 = (y2 * c + y1 * s) * osc;
                        if (n == 0) { w1.x = pk2(o1[0], o1[1]); w1.y = pk2(o1[2], o1[3]); w2.x = pk2(o2[0], o2[1]); w2.y = pk2(o2[2], o2[3]); }
                        else        { w1.z = pk2(o1[0], o1[1]); w1.w = pk2(o1[2], o1[3]); w2.z = pk2(o2[0], o2[1]); w2.w = pk2(o2[2], o2[3]); }
                    }
                    bf16_t* rowp = dst + (size_t)((row >> 13) * 8 + head) * 524288 + (size_t)(((pos & 15) * 32 + (pos >> 8)) * 8 + fq) * 128 + ((pos >> 4) & 15) * 8;
                    *(u32x4*)(rowp) = w1; *(u32x4*)(rowp + 4 * 128) = w2;
                }
        } else if (pn < 6) {
#pragma unroll
            for (int ai = 0; ai < 2; ++ai) {
                const int rbase = u.pm * 256 + ai * 128 + wr * 64; const int b = rbase >> 13, idx0 = (rbase & 8191) >> 4;
                float rs[4];
#pragma unroll
                for (int m = 0; m < 4; ++m) rs[m] = rs1[rbase + m * 16 + fr];
#pragma unroll
                for (int bj = 0; bj < 2; ++bj) { const int head = (pn - 4) * 4 + 2 * bj + (wc >> 1);
#pragma unroll
                    for (int n = 0; n < 2; ++n)
#pragma unroll
                        for (int i = 0; i < 4; ++i) { const int dim = (wc & 1) * 32 + 8 * fq + 4 * n + i;
                            u32x2 w; w.x = pk2(acc[ai][bj][0][n][i] * rs[0], acc[ai][bj][1][n][i] * rs[1]); w.y = pk2(acc[ai][bj][2][n][i] * rs[2], acc[ai][bj][3][n][i] * rs[3]);
                            *(u32x2*)(V + (size_t)(b * 8 + head) * 524288 + (size_t)((fr * 32 + (idx0 >> 4)) * 64 + dim) * 16 + (idx0 & 15)) = w; } }
            }
        } else {
            bf16_t* dst = P; const int colbase = (pn & 1) * 256 + wc * 32 + 8 * fq;
#pragma unroll
            for (int ai = 0; ai < 2; ++ai)
#pragma unroll
                for (int m = 0; m < 4; ++m) {
                    const int row = u.pm * 256 + ai * 128 + wr * 64 + m * 16 + fr; const float rs = rs1[row];
#pragma unroll
                    for (int bj = 0; bj < 2; ++bj) { const f32x4 a = acc[ai][bj][m][0] * rs, b = acc[ai][bj][m][1] * rs; u32x4 w; w.x = pk2(a[0], a[1]); w.y = pk2(a[2], a[3]); w.z = pk2(b[0], b[1]); w.w = pk2(b[2], b[3]);
                        *(u32x4*)(dst + (size_t)row * 512 + colbase + bj * 128) = w; }
                }
        }
    }
};
__device__ __forceinline__ int win_src_col(int n0p) { const int pn = n0p >> 8; if (pn >= 4) return n0p; const int bj = (n0p >> 7) & 1, wc = (n0p >> 5) & 3; return 512 * (pn >> 1) + (4 * (pn & 1) + wc) * 64 + 32 * bj; }

struct EpiOut {
    static constexpr bool PERM = false, AFTER_DRAIN = false;
    const bf16_t* xb; float* out; bf16_t* xb2; float* ss2;
    __device__ __forceinline__ void operator()(const f32x4 (&acc)[2][2][4][2], const pg8::Unit& u, int wr, int wc, int fr, int fq) const {
        const int col0 = u.pn * 256 + wc * 32 + 4 * fq;
#pragma unroll
        for (int ai = 0; ai < 2; ++ai)
#pragma unroll
            for (int m = 0; m < 4; ++m) {
                const int row = u.pm * 256 + ai * 128 + wr * 64 + m * 16 + fr; const size_t off = (size_t)row * D + col0; float ss = 0.f;
#pragma unroll
                for (int bj = 0; bj < 2; ++bj)
#pragma unroll
                    for (int n = 0; n < 2; ++n) { const u32x2 xw = *(const u32x2*)(xb + off + bj * 128 + n * 16); const f32x4 xv = {__uint_as_float(xw.x << 16), __uint_as_float(xw.x & 0xffff0000u), __uint_as_float(xw.y << 16), __uint_as_float(xw.y & 0xffff0000u)}; const f32x4 v = xv + acc[ai][bj][m][n];
                        ss += (v[0] * v[0] + v[1] * v[1]) + (v[2] * v[2] + v[3] * v[3]);
                        u32x2 w; w.x = pk2(v[0], v[1]); w.y = pk2(v[2], v[3]); *(u32x2*)(xb2 + off + bj * 128 + n * 16) = w; }
                ss += __shfl_xor(ss, 16); ss += __shfl_xor(ss, 32);
                if (fq == 0) ss2[(size_t)row * 16 + u.pn * 4 + wc] = ss;
            }
    }
};


__device__ __forceinline__ unsigned dpp_xor1(unsigned v) { return (unsigned)__builtin_amdgcn_update_dpp(0, (int)v, 0xB1, 0xf, 0xf, false); }
__device__ __forceinline__ unsigned dpp_xor2(unsigned v) { return (unsigned)__builtin_amdgcn_update_dpp(0, (int)v, 0x4E, 0xf, 0xf, false); }
__device__ __forceinline__ unsigned tag_of(unsigned t0, unsigned t1, unsigned t2, unsigned t3, int i) { const int w = i >> 2; const unsigned lo = (w & 1) ? t1 : t0, hi = (w & 1) ? t3 : t2; const unsigned d = (w & 2) ? hi : lo; return (d >> (8 * (i & 3))) & 0x7Fu; }
#define CE(a, b) do { const unsigned hi_ = (a) > (b) ? (a) : (b), lo_ = (a) > (b) ? (b) : (a); (a) = hi_; (b) = lo_; } while (0)
template <int O, int N> __device__ __forceinline__ void sort16_desc(unsigned (&k)[N]) {
    CE(k[O + 0], k[O + 1]); CE(k[O + 2], k[O + 3]); CE(k[O + 0], k[O + 2]); CE(k[O + 1], k[O + 3]); CE(k[O + 1], k[O + 2]); CE(k[O + 4], k[O + 5]); CE(k[O + 6], k[O + 7]); CE(k[O + 4], k[O + 6]); CE(k[O + 5], k[O + 7]); CE(k[O + 5], k[O + 6]); CE(k[O + 0], k[O + 4]); CE(k[O + 2], k[O + 6]); CE(k[O + 2], k[O + 4]); CE(k[O + 1], k[O + 5]); CE(k[O + 3], k[O + 7]); CE(k[O + 3], k[O + 5]); CE(k[O + 1], k[O + 2]); CE(k[O + 3], k[O + 4]); CE(k[O + 5], k[O + 6]); CE(k[O + 8], k[O + 9]); CE(k[O + 10], k[O + 11]); CE(k[O + 8], k[O + 10]); CE(k[O + 9], k[O + 11]); CE(k[O + 9], k[O + 10]); CE(k[O + 12], k[O + 13]); CE(k[O + 14], k[O + 15]); CE(k[O + 12], k[O + 14]); CE(k[O + 13], k[O + 15]); CE(k[O + 13], k[O + 14]); CE(k[O + 8], k[O + 12]); CE(k[O + 10], k[O + 14]); CE(k[O + 10], k[O + 12]); CE(k[O + 9], k[O + 13]); CE(k[O + 11], k[O + 15]); CE(k[O + 11], k[O + 13]); CE(k[O + 9], k[O + 10]); CE(k[O + 11], k[O + 12]); CE(k[O + 13], k[O + 14]); CE(k[O + 0], k[O + 8]); CE(k[O + 4], k[O + 12]); CE(k[O + 4], k[O + 8]); CE(k[O + 2], k[O + 10]); CE(k[O + 6], k[O + 14]); CE(k[O + 6], k[O + 10]); CE(k[O + 2], k[O + 4]); CE(k[O + 6], k[O + 8]); CE(k[O + 10], k[O + 12]); CE(k[O + 1], k[O + 9]); CE(k[O + 5], k[O + 13]); CE(k[O + 5], k[O + 9]); CE(k[O + 3], k[O + 11]); CE(k[O + 7], k[O + 15]); CE(k[O + 7], k[O + 11]); CE(k[O + 3], k[O + 5]); CE(k[O + 7], k[O + 9]); CE(k[O + 11], k[O + 13]); CE(k[O + 1], k[O + 2]); CE(k[O + 3], k[O + 4]); CE(k[O + 5], k[O + 6]); CE(k[O + 7], k[O + 8]); CE(k[O + 9], k[O + 10]); CE(k[O + 11], k[O + 12]); CE(k[O + 13], k[O + 14]);
}
__device__ __forceinline__ void merge16(unsigned (&a)[16], const unsigned (&b)[16]) {
#pragma unroll
    for (int i = 0; i < 16; ++i) a[i] = a[i] > b[15 - i] ? a[i] : b[15 - i];
#pragma unroll
    for (int d = 8; d >= 1; d >>= 1)
#pragma unroll
        for (int i = 0; i < 16; ++i) if ((i & d) == 0) CE(a[i], a[i + d]);
}
__device__ __forceinline__ unsigned cand_key(unsigned ka, unsigned kb, int a, int b) { const float sum = __uint_as_float(ka & ~0x7Fu) + __uint_as_float(kb & ~0x7Fu); return (__float_as_uint(sum) & ~0xFFu) | (unsigned)(255 - (16 * a + b)); }
struct EpiScores {
    static constexpr bool PERM = false, AFTER_DRAIN = true;
    const float* ss2; int* idx; float* gate;
    __device__ __forceinline__ void write_half(const f32x4 (&a)[2][4][2], LAS float* SC, int wr, int wc, int fr, int fq) const {
#pragma unroll
        for (int m = 0; m < 4; ++m)
#pragma unroll
            for (int bj = 0; bj < 2; ++bj)
#pragma unroll
                for (int n = 0; n < 2; ++n) { const int rl = 64 * wr + 16 * m + fr, qq = 2 * bj + (wc >> 1), k = 8 * (wc & 1) + 4 * n + fq;
                    *(LAS f32x4*)(SC + rl * 256 + 64 * qq + 4 * ((k + rl + 4 * qq) & 15)) = a[bj][m][n]; }
    }
    __device__ __forceinline__ void select_half(LAS float* SC, int row0, int pn, int wid, int lane) const {
        const int q = lane & 3, rl = 16 * wid + (lane >> 2), rot = (rl + 4 * q) & 15;
        const int row = row0 + rl;
        float rs; { const f32x4 s0 = *(const f32x4*)(ss2 + (size_t)row * 16), s1 = *(const f32x4*)(ss2 + (size_t)row * 16 + 4), s2 = *(const f32x4*)(ss2 + (size_t)row * 16 + 8), s3 = *(const f32x4*)(ss2 + (size_t)row * 16 + 12);
          const float t = ((s0[0] + s0[1]) + (s0[2] + s0[3])) + ((s1[0] + s1[1]) + (s1[2] + s1[3])) + ((s2[0] + s2[1]) + (s2[2] + s2[3])) + ((s3[0] + s3[1]) + (s3[2] + s3[3]));
          rs = 1.0f / sqrtf(t * (1.0f / D) + EPS); }
        unsigned tk[16];
        { unsigned key[64];
#pragma unroll
          for (int k = 0; k < 16; ++k) { const f32x4 v = *(const LAS f32x4*)(SC + rl * 256 + 64 * q + 4 * ((k + rot) & 15));
#pragma unroll
              for (int i = 0; i < 4; ++i) { const float sc = __builtin_amdgcn_fmed3f(v[i] * rs + 8.0f, 0.125f, 15.875f); key[4 * k + i] = (__float_as_uint(sc) & ~0x7Fu) | (unsigned)(63 - (4 * k + i)); } }
          asm volatile("s_waitcnt lgkmcnt(0)" ::: "memory"); __builtin_amdgcn_s_barrier(); asm volatile("" ::: "memory");
          sort16_desc<0, 64>(key); sort16_desc<16, 64>(key); sort16_desc<32, 64>(key); sort16_desc<48, 64>(key);
          unsigned t1[16], t2[16], t3[16];
#pragma unroll
          for (int i = 0; i < 16; ++i) { tk[i] = key[i]; t1[i] = key[16 + i]; t2[i] = key[32 + i]; t3[i] = key[48 + i]; }
          merge16(tk, t1); merge16(t2, t3); merge16(tk, t2);
          const unsigned cbit = (q & 1) ? 0u : 64u;
#pragma unroll
          for (int i = 0; i < 16; ++i) tk[i] |= cbit; }
        unsigned c[16];
#pragma unroll
        for (int i = 0; i < 16; ++i) { const unsigned o = dpp_xor1(tk[15 - i]); c[i] = tk[i] > o ? tk[i] : o; }
#pragma unroll
        for (int d = 8; d >= 1; d >>= 1)
#pragma unroll
            for (int i = 0; i < 16; ++i) if ((i & d) == 0) { const unsigned hi = c[i] > c[i + d] ? c[i] : c[i + d], lo = c[i] > c[i + d] ? c[i + d] : c[i]; c[i] = hi; c[i + d] = lo; }
        unsigned ka[16], kb[16]; const bool ph = (q & 2) != 0;
#pragma unroll
        for (int i = 0; i < 16; ++i) { const unsigned o = dpp_xor2(c[i]); ka[i] = ph ? o : c[i]; kb[i] = ph ? c[i] : o; }
        unsigned best[16];
        { unsigned l1[16], sx[16], l6[16];
#pragma unroll
          for (int b = 0; b < 16; ++b) best[b] = cand_key(ka[0], kb[b], 0, b);
#pragma unroll
          for (int a = 1; a < 16; ++a) l1[a - 1] = cand_key(ka[a], kb[0], a, 0);
          l1[15] = 0u;
#pragma unroll
          for (int b = 1; b <= 7; ++b) sx[b - 1] = cand_key(ka[1], kb[b], 1, b);
#pragma unroll
          for (int b = 1; b <= 4; ++b) sx[6 + b] = cand_key(ka[2], kb[b], 2, b);
#pragma unroll
          for (int b = 1; b <= 3; ++b) sx[10 + b] = cand_key(ka[3], kb[b], 3, b);
          sx[14] = cand_key(ka[4], kb[1], 4, 1); sx[15] = cand_key(ka[4], kb[2], 4, 2);
          l6[0] = cand_key(ka[5], kb[1], 5, 1); l6[1] = cand_key(ka[6], kb[1], 6, 1); l6[2] = cand_key(ka[7], kb[1], 7, 1);
#pragma unroll
          for (int i = 3; i < 16; ++i) l6[i] = 0u;
          merge16(best, l1); sort16_desc<0, 16>(sx); merge16(sx, l6); merge16(best, sx); }
        const float v0 = __uint_as_float(best[0] & ~0xFFu);
        float esum = 0.f;
#pragma unroll
        for (int r = 0; r < 16; ++r) esum += exp2f((__uint_as_float(best[r] & ~0xFFu) - v0) * 1.4426950408889634f);
        const float inv = 1.0f / esum;
#define PK4(k, w) (((k)[4 * (w)] & 0x7Fu) | (((k)[4 * (w) + 1] & 0x7Fu) << 8) | (((k)[4 * (w) + 2] & 0x7Fu) << 16) | (((k)[4 * (w) + 3] & 0x7Fu) << 24))
        const unsigned ta0 = PK4(ka, 0), ta1 = PK4(ka, 1), ta2 = PK4(ka, 2), ta3 = PK4(ka, 3), tb0 = PK4(kb, 0), tb1 = PK4(kb, 1), tb2 = PK4(kb, 2), tb3 = PK4(kb, 3);
#undef PK4
        int oi[4]; float og[4];
#pragma unroll
        for (int i = 0; i < 4; ++i) { const unsigned b_ = q == 0 ? best[i] : (q == 1 ? best[4 + i] : (q == 2 ? best[8 + i] : best[12 + i]));
            const int id = 255 - (int)(b_ & 0xFFu), a_ = id >> 4, bb = id & 15;
            const int i1 = 127 - (int)tag_of(ta0, ta1, ta2, ta3, a_), i2 = 127 - (int)tag_of(tb0, tb1, tb2, tb3, bb);
            oi[i] = i1 * 128 + i2; og[i] = exp2f((__uint_as_float(b_ & ~0xFFu) - v0) * 1.4426950408889634f) * inv; }
#pragma unroll
        for (int i = 0; i < 4; ++i) { const size_t o = (size_t)row * 128 + (4 * (q & 1) + i) * 16 + 2 * pn + (q >> 1); ((unsigned short*)idx)[o] = (unsigned short)oi[i]; gate[o] = og[i]; }
    }
    __device__ __forceinline__ void fused(f32x4 (&acc)[2][2][4][2], const pg8::Unit& u, int wr, int wc, int fr, int fq, LAS unsigned char* lds, int wid, int lane) const {
        LAS float* SC = (LAS float*)lds;
        asm volatile("" : "+v"(lane), "+v"(fr), "+v"(fq));
        write_half(acc[0], SC, wr, wc, fr, fq);
        asm volatile("s_waitcnt lgkmcnt(0)" ::: "memory"); __builtin_amdgcn_s_barrier(); asm volatile("" ::: "memory");
        select_half(SC, u.pm * 256, u.pn, wid, lane);
        asm volatile("" : "+v"(lane), "+v"(fr), "+v"(fq));
        write_half(acc[1], SC, wr, wc, fr, fq);
        asm volatile("s_waitcnt lgkmcnt(0)" ::: "memory"); __builtin_amdgcn_s_barrier(); asm volatile("" ::: "memory");
        select_half(SC, u.pm * 256 + 128, u.pn, wid, lane);
    }
};
struct SingleUnit { pg8::Unit u;
    __device__ __forceinline__ bool next(int i, pg8::Unit& o) const { if (i != 0) return false; o = u; return true; }
    __device__ __forceinline__ void a_ready(const pg8::Unit&) const {}
    __device__ __forceinline__ void done(const pg8::Unit&) const {}
};


typedef short bf16x8 __attribute__((ext_vector_type(8)));
typedef short s16x4 __attribute__((ext_vector_type(4)));
struct AttnFrag { bf16x8 k00, k01, k10, k11; s16x4 v0[4], v1[4]; };
__device__ __forceinline__ void attn_load(AttnFrag& f, const bf16_t* __restrict__ Kc, const bf16_t* __restrict__ VT, size_t plane, int c0, int kb0, int c1, int kb1, int li, int lg) {
    const bf16_t* k0 = Kc + plane + (size_t)((c0 * 32 + (kb0 >> 4)) * 8 + lg) * 128 + li * 8; const bf16_t* k1 = Kc + plane + (size_t)((c1 * 32 + (kb1 >> 4)) * 8 + lg) * 128 + li * 8;
    f.k00 = *(const bf16x8*)k0; f.k01 = *(const bf16x8*)(k0 + 4 * 128); f.k10 = *(const bf16x8*)k1; f.k11 = *(const bf16x8*)(k1 + 4 * 128);
    const bf16_t* v0 = VT + plane + (size_t)(c0 * 32 + (kb0 >> 4)) * 1024 + li * 16 + 4 * lg; const bf16_t* v1 = VT + plane + (size_t)(c1 * 32 + (kb1 >> 4)) * 1024 + li * 16 + 4 * lg;
#pragma unroll
    for (int mt = 0; mt < 4; ++mt) { f.v0[mt] = *(const s16x4*)(v0 + mt * 256); f.v1[mt] = *(const s16x4*)(v1 + mt * 256); }
}
template <int TY> __device__ __forceinline__ float attn_w(int d) {
    if (TY == 3) return 1.f;
    float w = (unsigned)d <= 128u ? 1.f : 0.f;
    if (TY <= 1) w += (unsigned)d <= 512u ? 1.f : 0.f;
    if (TY == 0) w += (unsigned)d <= 2048u ? 1.f : 0.f;
    return w;
}
template <int T0, int T1> __device__ __forceinline__ void attn_step(const AttnFrag& f, const bf16x8 qf0, const bf16x8 qf1, int db0, int db1, f32x4 (&O)[4], float& lsum) {
    f32x4 s0 = {0.f, 0.f, 0.f, 0.f}, s1 = {0.f, 0.f, 0.f, 0.f};
    s0 = __builtin_amdgcn_mfma_f32_16x16x32_bf16(f.k00, qf0, s0, 0, 0, 0); s0 = __builtin_amdgcn_mfma_f32_16x16x32_bf16(f.k01, qf1, s0, 0, 0, 0);
    s1 = __builtin_amdgcn_mfma_f32_16x16x32_bf16(f.k10, qf0, s1, 0, 0, 0); s1 = __builtin_amdgcn_mfma_f32_16x16x32_bf16(f.k11, qf1, s1, 0, 0, 0);
    float p0[4], p1[4];
#pragma unroll
    for (int j = 0; j < 4; ++j) { p0[j] = attn_w<T0>(db0 - 16 * j) * __builtin_amdgcn_exp2f(s0[j]); p1[j] = attn_w<T1>(db1 - 16 * j) * __builtin_amdgcn_exp2f(s1[j]); }
    lsum += ((p0[0] + p0[1]) + (p0[2] + p0[3])) + ((p1[0] + p1[1]) + (p1[2] + p1[3]));
    u32x4 pw; pw.x = pk2(p0[0], p0[1]); pw.y = pk2(p0[2], p0[3]); pw.z = pk2(p1[0], p1[1]); pw.w = pk2(p1[2], p1[3]);
    const bf16x8 pf = __builtin_bit_cast(bf16x8, pw);
#pragma unroll
    for (int mt = 0; mt < 4; ++mt) { const bf16x8 vf = {f.v0[mt][0], f.v0[mt][1], f.v0[mt][2], f.v0[mt][3], f.v1[mt][0], f.v1[mt][1], f.v1[mt][2], f.v1[mt][3]};
        O[mt] = __builtin_amdgcn_mfma_f32_16x16x32_bf16(vf, pf, O[mt], 0, 0, 0); }
}
constexpr int ATT_LDS_V = 65536;
__device__ __forceinline__ void attn_stage(LAS unsigned char* lds, const bf16_t* __restrict__ Kc, const bf16_t* __restrict__ VT, size_t plane, int sp, int wave, int lane) {
    const int tprev = sp > 0 ? sp - 1 : 0;
#pragma unroll
    for (int i = 0; i < 16; ++i) { const int q = wave * 16 + i, isv = q >> 6, slot = (q >> 1) & 31, half = q & 1; const int c = slot >> 1, ti = (slot & 1) ? sp : tprev;
        const bf16_t* src = (isv ? VT : Kc) + plane + (size_t)(c * 32 + ti) * 1024 + half * 512 + lane * 8;
        __builtin_amdgcn_global_load_lds((const unsigned*)src, (LAS unsigned*)(lds + isv * ATT_LDS_V + slot * 2048 + half * 1024), 16, 0, 0); }
}
__device__ __forceinline__ void attn_load_lds(AttnFrag& f, const LAS unsigned char* lds, int c, int li, int lg) {
    const LAS unsigned char* k0 = lds + (2 * c) * 2048 + lg * 256 + li * 16; const LAS unsigned char* v0 = lds + ATT_LDS_V + (2 * c) * 2048 + li * 32 + lg * 8;
    f.k00 = *(const LAS bf16x8*)k0; f.k01 = *(const LAS bf16x8*)(k0 + 1024); f.k10 = *(const LAS bf16x8*)(k0 + 2048); f.k11 = *(const LAS bf16x8*)(k0 + 2048 + 1024);
#pragma unroll
    for (int mt = 0; mt < 4; ++mt) { f.v0[mt] = *(const LAS s16x4*)(v0 + mt * 512); f.v1[mt] = *(const LAS s16x4*)(v0 + 2048 + mt * 512); }
}
constexpr float U8_SCALE = 95.46f, X8_SCALE = 12.f, V4_SCALE = 5.656854f;
struct TabRow { f32x4 u[4], v[4]; };
__device__ __forceinline__ void tab_load1(TabRow& t, int row, int lane, const float* __restrict__ pu, const float* __restrict__ pv) {
#pragma unroll
    for (int q4 = 0; q4 < 4; ++q4) { const size_t o = (size_t)row * 1024 + 512 * (q4 >> 1) + 8 * lane + 4 * (q4 & 1); t.u[q4] = *(const f32x4*)(pu + o); t.v[q4] = *(const f32x4*)(pv + o); }
}
__device__ __forceinline__ float clamp6(float x) { return fminf(fmaxf(x, -6.0f), 6.0f); }
__device__ __forceinline__ void tab_store1(const TabRow& t, int row, int lane, const float* __restrict__ g2, unsigned char* __restrict__ U8, unsigned char* __restrict__ V8) {
#pragma unroll
    for (int q2 = 0; q2 < 2; ++q2) { unsigned wu = 0; unsigned wv = 0;
#pragma unroll
        for (int hh = 0; hh < 2; ++hh) { const int q4 = 2 * q2 + hh; const f32x4 gq = *(const f32x4*)(g2 + 512 * q2 + 8 * lane + 4 * hh); const f32x4 a = t.u[q4], c = t.v[q4];
#pragma unroll
            for (int k = 0; k < 4; ++k) { int qi = (int)floorf(a[k] * gq[k] * U8_SCALE); qi = qi < -8 ? -8 : qi > 7 ? 7 : qi; wu |= (unsigned)(qi & 15) << (16 * hh + 4 * k); }
            if (hh == 0) { wv = __builtin_amdgcn_cvt_scalef32_pk_fp4_f32(wv, clamp6(c[0] * V4_SCALE), clamp6(c[1] * V4_SCALE), 1.0f, 0); wv = __builtin_amdgcn_cvt_scalef32_pk_fp4_f32(wv, clamp6(c[2] * V4_SCALE), clamp6(c[3] * V4_SCALE), 1.0f, 1); }
            else         { wv = __builtin_amdgcn_cvt_scalef32_pk_fp4_f32(wv, clamp6(c[0] * V4_SCALE), clamp6(c[1] * V4_SCALE), 1.0f, 2); wv = __builtin_amdgcn_cvt_scalef32_pk_fp4_f32(wv, clamp6(c[2] * V4_SCALE), clamp6(c[3] * V4_SCALE), 1.0f, 3); } }
        *(unsigned*)(U8 + (size_t)row * 512 + 256 * q2 + 4 * lane) = wu;
        *(unsigned*)(V8 + (size_t)row * 512 + 256 * q2 + 4 * lane) = wv; }
}
__device__ __forceinline__ void attn_task(int b, int h, int sp, int r, int lane, const LAS unsigned char* lds, const bf16_t* __restrict__ Qc, const bf16_t* __restrict__ Kc, const bf16_t* __restrict__ VT, bf16_t* __restrict__ mix,
                                          int trow, const float* __restrict__ pu, const float* __restrict__ pv, const float* __restrict__ g2, unsigned char* __restrict__ U8, unsigned char* __restrict__ V8) {
    const int li = lane & 15, lg = lane >> 4, qb = 16 * sp;
    const size_t plane = (size_t)(b * 8 + h) * 8192 * 64;
    const bf16_t* qp = Qc + plane + (size_t)((r * 32 + sp) * 8 + lg) * 128 + li * 8;
    const bf16x8 qf0 = *(const bf16x8*)qp, qf1 = *(const bf16x8*)(qp + 4 * 128);
    f32x4 O[4];
#pragma unroll
    for (int mt = 0; mt < 4; ++mt) O[mt] = (f32x4){0.f, 0.f, 0.f, 0.f};
    float lsum = 0.f;
    const int qd = 16 * (qb + li - 4 * lg);
    const int INV = -(1 << 24);
    {
        AttnFrag fa, fb;
        const int c1 = (r - 4) & 15, c2 = (r - 8) & 15, c3 = (r - 12) & 15, kb2 = qb - 32;
        const bool v2 = kb2 >= 0; const int kb2c = v2 ? kb2 : 0;
#define KBC(k) ((k) < 0 ? 0 : (k))
#define OV(k, o) ((k) < 0 ? INV : (o))
        attn_load(fa, Kc, VT, plane, r, KBC(qb - 128), r, KBC(qb - 112), li, lg);
        attn_load(fb, Kc, VT, plane, r, KBC(qb - 96), r, KBC(qb - 80), li, lg);
        if (qb >= 128) attn_step<0, 3>(fa, qf0, qf1, qd - 16 * (qb - 128), 0, O, lsum); else attn_step<0, 0>(fa, qf0, qf1, qd - 16 * KBC(qb - 128) + OV(qb - 128, 0), qd - 16 * KBC(qb - 112) + OV(qb - 112, 0), O, lsum);
        attn_load(fa, Kc, VT, plane, r, KBC(qb - 64), r, KBC(qb - 48), li, lg);
        if (qb >= 128) attn_step<3, 3>(fb, qf0, qf1, 0, 0, O, lsum); else attn_step<0, 0>(fb, qf0, qf1, qd - 16 * KBC(qb - 96) + OV(qb - 96, 0), qd - 16 * KBC(qb - 80) + OV(qb - 80, 0), O, lsum);
        attn_load(fb, Kc, VT, plane, r, kb2c, c1, kb2c, li, lg);
        if (qb >= 128) attn_step<3, 3>(fa, qf0, qf1, 0, 0, O, lsum); else attn_step<0, 0>(fa, qf0, qf1, qd - 16 * KBC(qb - 64) + OV(qb - 64, 0), qd - 16 * KBC(qb - 48) + OV(qb - 48, 0), O, lsum);
        attn_load(fa, Kc, VT, plane, c2, kb2c, c3, kb2c, li, lg);
        attn_step<0, 1>(fb, qf0, qf1, qd - 16 * kb2c + OV(kb2, 0), qd - 16 * kb2c + OV(kb2, r - c1), O, lsum);
        attn_step<1, 1>(fa, qf0, qf1, qd - 16 * kb2c + OV(kb2, r - c2), qd - 16 * kb2c + OV(kb2, r - c3), O, lsum);
#undef KBC
#undef OV
    }
    TabRow trw; if (trow >= 0) tab_load1(trw, trow, lane, pu, pv);
    const int kbp = sp > 0 ? qb - 16 : 0; const bool vp = sp > 0;
    const int dP = qd - 16 * kbp + (vp ? 0 : INV), dC = qd - 16 * qb;
#define CLS_B(e) ((r - 4 * (e)) & 15)
#define CLS_C(x) ((r + (x) + 1 + (x) / 3) & 15)
    {
        AttnFrag fa, fb;
        attn_load_lds(fa, lds, r, li, lg);
        attn_load_lds(fb, lds, CLS_B(1), li, lg); attn_step<0, 0>(fa, qf0, qf1, dP, dC, O, lsum);
        attn_load_lds(fa, lds, CLS_B(2), li, lg); { const int o = r - CLS_B(1); attn_step<1, 1>(fb, qf0, qf1, dP + o, dC + o, O, lsum); }
        attn_load_lds(fb, lds, CLS_B(3), li, lg); { const int o = r - CLS_B(2); attn_step<1, 1>(fa, qf0, qf1, dP + o, dC + o, O, lsum); }
        attn_load_lds(fa, lds, CLS_C(0), li, lg); { const int o = r - CLS_B(3); attn_step<1, 1>(fb, qf0, qf1, dP + o, dC + o, O, lsum); }
#pragma unroll 1
        for (int x = 0; x < 12; x += 2) {
            attn_load_lds(fb, lds, CLS_C(x + 1), li, lg); { const int o = r - CLS_C(x); attn_step<2, 2>(fa, qf0, qf1, dP + o, dC + o, O, lsum); }
            const int xn = x + 2 < 12 ? x + 2 : 11;
            attn_load_lds(fa, lds, CLS_C(xn), li, lg); { const int o = r - CLS_C(x + 1); attn_step<2, 2>(fb, qf0, qf1, dP + o, dC + o, O, lsum); }
        }
    }
#undef CLS_B
#undef CLS_C
    if (trow >= 0) tab_store1(trw, trow, lane, g2, U8, V8);
    lsum += __shfl_xor(lsum, 16); lsum += __shfl_xor(lsum, 32);
    const float inv = 1.0f / lsum;
    bf16_t* op = mix + (size_t)(b * 8192 + 16 * (qb + li) + r) * 1024 + h * 64 + 4 * lg;
#pragma unroll
    for (int mt = 0; mt < 4; ++mt) { u32x2 w; w.x = pk2(O[mt][0] * inv, O[mt][1] * inv); w.y = pk2(O[mt][2] * inv, O[mt][3] * inv); *(u32x2*)(op + 16 * mt) = w; }
}

template <int W> __device__ __forceinline__ void pooled_task(int tq, int g, int lane, const bf16_t* __restrict__ P, bf16_t* __restrict__ mix) {
    const int t = 4 * tq + (lane >> 4), pos = t & (S - 1), ch = g * 128 + 8 * (lane & 15); const int cnt = (pos + 1) < W ? (pos + 1) : W; const float rc = 1.0f / (float)cnt;
    const bf16_t* pp = P + (size_t)t * 512 + ch;
    u32x4 wv[W];
#pragma unroll
    for (int sft = 0; sft < W; ++sft) wv[sft] = *(const u32x4*)(pp - (size_t)(sft < cnt ? sft : 0) * 512);
    float sum[8], self[8];
#pragma unroll
    for (int j = 0; j < 8; ++j) sum[j] = 0.f;
#pragma unroll
    for (int sft = 0; sft < W; ++sft) { const unsigned vv[4] = {wv[sft].x, wv[sft].y, wv[sft].z, wv[sft].w}; const float wgt = sft < cnt ? 1.f : 0.f;
#pragma unroll
        for (int j = 0; j < 4; ++j) { const float lo = __uint_as_float(vv[j] << 16), hi = __uint_as_float(vv[j] & 0xffff0000u);
            if (sft == 0) { self[2 * j] = lo; self[2 * j + 1] = hi; }
            sum[2 * j] += wgt * lo; sum[2 * j + 1] += wgt * hi; } }
    u32x4 pw; pw.x = pk2(sum[0] * rc - self[0], sum[1] * rc - self[1]); pw.y = pk2(sum[2] * rc - self[2], sum[3] * rc - self[3]);
    pw.z = pk2(sum[4] * rc - self[4], sum[5] * rc - self[5]); pw.w = pk2(sum[6] * rc - self[6], sum[7] * rc - self[7]);
    *(u32x4*)(mix + (size_t)t * 1024 + 512 + ch) = pw;
}
__device__ __forceinline__ void mm128x64_f32(const LAS float* S_l, const LAS float* A_l, int wave, int lane, f32x4 (&acc)[4]);
__device__ __forceinline__ void p0_poolfold_item(int item, int tid, LAS float* lf, const float* __restrict__ w_out, const float* __restrict__ pool_w, const float* __restrict__ pool_scale, bf16_t* __restrict__ WoutT) {
    const int g = item >> 4, n0 = (item & 15) * 64, wave = tid >> 6, lane = tid & 63;
    LAS float* A_l = lf; LAS float* S_l = lf + 64 * 132;
#pragma unroll 4
    for (int i = 0; i < 16; ++i) { const int e = tid + 512 * i, d = e >> 6, kl = e & 63; A_l[kl * 132 + d] = w_out[(size_t)(512 + 128 * g + d) * 1024 + n0 + kl]; }
#pragma unroll 4
    for (int i = 0; i < 32; ++i) { const int e = tid + 512 * i; S_l[(e >> 7) * 132 + (e & 127)] = pool_w[(size_t)g * 16384 + e] * pool_scale[g * 128 + (e & 127)]; }
    __syncthreads();
    f32x4 acc[4]; mm128x64_f32(S_l, A_l, wave, lane, acc);
    const int j = lane & 15, q = lane >> 4;
#pragma unroll
    for (int nt = 0; nt < 4; ++nt) { u32x2 o; o.x = pk2(acc[nt][0], acc[nt][1]); o.y = pk2(acc[nt][2], acc[nt][3]);
        *(u32x2*)(WoutT + (size_t)(n0 + 16 * nt + j) * 1024 + 512 + 128 * g + 16 * wave + 4 * q) = o; }
    __syncthreads();
}

__device__ __forceinline__ void p0_transpose_item(const float* __restrict__ W, int ldw, int src_col0, const float* __restrict__ gk, bf16_t* __restrict__ WT, int Kdim, int k0, int dst_row0, LAS float* scr, int lane) {
#pragma unroll 8
    for (int i = 0; i < 32; ++i) { const int kk = 2 * i + (lane >> 5); float v = W[(size_t)(k0 + kk) * ldw + src_col0 + (lane & 31)]; if (gk) v *= gk[k0 + kk]; scr[kk * 33 + (lane & 31)] = v; }
    asm volatile("s_waitcnt lgkmcnt(0)" ::: "memory");
    const int c = lane & 7;
#pragma unroll
    for (int j = 0; j < 4; ++j) { const int n = (lane >> 3) + 8 * j; const LAS float* s = scr + (8 * c) * 33 + n;
        u32x4 o; o.x = pk2(s[0 * 33], s[1 * 33]); o.y = pk2(s[2 * 33], s[3 * 33]); o.z = pk2(s[4 * 33], s[5 * 33]); o.w = pk2(s[6 * 33], s[7 * 33]);
        *(u32x4*)(WT + (size_t)(dst_row0 + n) * Kdim + k0 + 8 * c) = o; }
    asm volatile("s_waitcnt lgkmcnt(0)" ::: "memory");
}
__device__ __forceinline__ void mm128x64_f32(const LAS float* S_l, const LAS float* A_l, int wave, int lane, f32x4 (&acc)[4]) {
    const int i = lane & 15, kq = lane >> 4;
#pragma unroll
    for (int nt = 0; nt < 4; ++nt) acc[nt] = (f32x4){0.f, 0.f, 0.f, 0.f};
    const LAS float* sp = S_l + (16 * wave + i) * 132 + kq; const LAS float* ap = A_l + i * 132 + kq;
#pragma unroll 4
    for (int ks = 0; ks < 32; ++ks) { const float sv = sp[4 * ks];
#pragma unroll
        for (int nt = 0; nt < 4; ++nt) acc[nt] = __builtin_amdgcn_mfma_f32_16x16x4f32(sv, ap[nt * 16 * 132 + 4 * ks], acc[nt], 0, 0, 0); }
}
__device__ __forceinline__ void p0_wprime_item(int item, int tid, LAS float* lf, const float* __restrict__ wq, const float* __restrict__ sk, const float* __restrict__ g2, bf16_t* __restrict__ WscT) {
    const int hp = item >> 4, k0 = (item & 15) * 64, wave = tid >> 6, lane = tid & 63;
    LAS float* A_l = lf; LAS float* S_l = lf + 64 * 132;
#pragma unroll 4
    for (int i = 0; i < 16; ++i) { const int e = tid + 512 * i, r = e >> 7, c = e & 127; A_l[r * 132 + c] = wq[(size_t)(k0 + r) * 2048 + hp * 128 + c] * g2[k0 + r]; }
#pragma unroll 4
    for (int i = 0; i < 32; ++i) { const int e = tid + 512 * i; S_l[(e >> 7) * 132 + (e & 127)] = sk[(size_t)hp * 16384 + e]; }
    __syncthreads();
    f32x4 acc[4]; mm128x64_f32(S_l, A_l, wave, lane, acc);
    const int j = lane & 15, q = lane >> 4;
#pragma unroll
    for (int nt = 0; nt < 4; ++nt)
#pragma unroll
        for (int r = 0; r < 4; ++r) WscT[(size_t)(hp * 128 + 16 * wave + 4 * q + r) * 1024 + k0 + 16 * nt + j] = (bf16_t)f2bf(acc[nt][r]);
    __syncthreads();
}

__device__ __forceinline__ float dot2u(unsigned a, unsigned b, float acc) { return __builtin_amdgcn_fdot2_f32_bf16(__builtin_bit_cast(bf16x2_t, a), __builtin_bit_cast(bf16x2_t, b), acc, false); }
__device__ __forceinline__ unsigned fp8x2_bf16(unsigned w, bool hi) { return hi ? __builtin_bit_cast(unsigned, __builtin_amdgcn_cvt_scalef32_pk_bf16_fp8(w, 1.0f, true)) : __builtin_bit_cast(unsigned, __builtin_amdgcn_cvt_scalef32_pk_bf16_fp8(w, 1.0f, false)); }
__device__ __forceinline__ float dot16_fp8(const u32x4 u, const unsigned (&xq)[8]) {
    const unsigned w0 = u.x, w1 = u.y, w2 = u.z, w3 = u.w; float a = 0.f, b = 0.f;
    a = dot2u(fp8x2_bf16(w0, false), xq[0], a); b = dot2u(fp8x2_bf16(w0, true), xq[1], b);
    a = dot2u(fp8x2_bf16(w1, false), xq[2], a); b = dot2u(fp8x2_bf16(w1, true), xq[3], b);
    a = dot2u(fp8x2_bf16(w2, false), xq[4], a); b = dot2u(fp8x2_bf16(w2, true), xq[5], b);
    a = dot2u(fp8x2_bf16(w3, false), xq[6], a); b = dot2u(fp8x2_bf16(w3, true), xq[7], b);
    return a + b;
}
__device__ __forceinline__ unsigned fp4x2_bf16(unsigned w, int b) { return b == 0 ? __builtin_bit_cast(unsigned, __builtin_amdgcn_cvt_scalef32_pk_bf16_fp4(w, 1.0f, 0)) : b == 1 ? __builtin_bit_cast(unsigned, __builtin_amdgcn_cvt_scalef32_pk_bf16_fp4(w, 1.0f, 1))
                                                                            : b == 2 ? __builtin_bit_cast(unsigned, __builtin_amdgcn_cvt_scalef32_pk_bf16_fp4(w, 1.0f, 2)) : __builtin_bit_cast(unsigned, __builtin_amdgcn_cvt_scalef32_pk_bf16_fp4(w, 1.0f, 3)); }
__device__ __forceinline__ float dot32_fp4(const u32x4 u, const unsigned (&xq)[16]) {
    const unsigned w[4] = {u.x, u.y, u.z, u.w}; float a = 0.f, b = 0.f;
#pragma unroll
    for (int i = 0; i < 4; ++i) { unsigned wi = w[i]; asm volatile("" : "+v"(wi), "+v"(a));
        a = dot2u(fp4x2_bf16(wi, 0), xq[4 * i], a); b = dot2u(fp4x2_bf16(wi, 1), xq[4 * i + 1], b); a = dot2u(fp4x2_bf16(wi, 2), xq[4 * i + 2], a); b = dot2u(fp4x2_bf16(wi, 3), xq[4 * i + 3], b); }
    return a + b;
}
typedef float f32x2 __attribute__((ext_vector_type(2)));
__device__ __forceinline__ void fma16_fp8(float (&y)[16], const u32x4 v, float s) {
    const unsigned w[4] = {v.x, v.y, v.z, v.w};
#pragma unroll
    for (int i = 0; i < 4; ++i) { const f32x2 lo = __builtin_amdgcn_cvt_scalef32_pk_f32_fp8(w[i], 1.0f, false), hi = __builtin_amdgcn_cvt_scalef32_pk_f32_fp8(w[i], 1.0f, true);
        y[4 * i] += s * lo[0]; y[4 * i + 1] += s * lo[1]; y[4 * i + 2] += s * hi[0]; y[4 * i + 3] += s * hi[1]; }
}
__device__ __forceinline__ void fma32_fp4(float (&y)[32], const u32x4 v, float s) {
    const unsigned w[4] = {v.x, v.y, v.z, v.w};
#pragma unroll
    for (int i = 0; i < 4; ++i) { unsigned wi = w[i]; asm volatile("" : "+v"(wi), "+v"(y[8 * i]));
        const f32x2 p0 = __builtin_amdgcn_cvt_scalef32_pk_f32_fp4(wi, 1.0f, 0), p1 = __builtin_amdgcn_cvt_scalef32_pk_f32_fp4(wi, 1.0f, 1), p2 = __builtin_amdgcn_cvt_scalef32_pk_f32_fp4(wi, 1.0f, 2), p3 = __builtin_amdgcn_cvt_scalef32_pk_f32_fp4(wi, 1.0f, 3);
        y[8 * i] += s * p0[0]; y[8 * i + 1] += s * p0[1]; y[8 * i + 2] += s * p1[0]; y[8 * i + 3] += s * p1[1]; y[8 * i + 4] += s * p2[0]; y[8 * i + 5] += s * p2[1]; y[8 * i + 6] += s * p3[0]; y[8 * i + 7] += s * p3[1]; }
}
typedef _Float16 h16x2 __attribute__((ext_vector_type(2)));
__device__ __forceinline__ void fma32_fp4h(h16x2 (&y)[16], const u32x4 v, const h16x2 a2) {
    const unsigned w[4] = {v.x, v.y, v.z, v.w};
#pragma unroll
    for (int i = 0; i < 4; ++i) { const unsigned wi = w[i];
        y[4 * i] = __builtin_amdgcn_cvt_scalef32_pk_f16_fp4(wi, 1.0f, 0) * a2 + y[4 * i]; y[4 * i + 1] = __builtin_amdgcn_cvt_scalef32_pk_f16_fp4(wi, 1.0f, 1) * a2 + y[4 * i + 1];
        y[4 * i + 2] = __builtin_amdgcn_cvt_scalef32_pk_f16_fp4(wi, 1.0f, 2) * a2 + y[4 * i + 2]; y[4 * i + 3] = __builtin_amdgcn_cvt_scalef32_pk_f16_fp4(wi, 1.0f, 3) * a2 + y[4 * i + 3]; }
}
__device__ __forceinline__ h16x2 bc_h2(float a) { return __builtin_bit_cast(h16x2, __builtin_amdgcn_cvt_pkrtz(a, a)); }
__device__ __forceinline__ h16x2 shfl_h2(h16x2 v, int m) { return __builtin_bit_cast(h16x2, __shfl_xor(__builtin_bit_cast(unsigned, v), m)); }
__device__ __forceinline__ void p5_ids(unsigned (&e)[8], size_t t, int lane, const int* __restrict__ idx) {
    const int eg = lane >> 3; const unsigned ob = ((unsigned)t * 128u + (unsigned)(eg * 16)) << 1;
    const u32x4 a = *(const u32x4*)((const char*)idx + ob), b = *(const u32x4*)((const char*)idx + ob + 16u);
    e[0] = a.x; e[1] = a.y; e[2] = a.z; e[3] = a.w; e[4] = b.x; e[5] = b.y; e[6] = b.z; e[7] = b.w;
}
__device__ __forceinline__ void p5_pay(unsigned (&xq)[16], size_t t, int sl, int lane, const bf16_t* __restrict__ xb2) {
    const int m = lane & 7; const unsigned ob = ((unsigned)t * 1024u + (unsigned)(256 * sl + 32 * m)) << 1;
#pragma unroll
    for (int i = 0; i < 4; ++i) { const u32x4 xa = *(const u32x4*)((const char*)xb2 + ob + 16u * i); xq[4 * i] = xa.x; xq[4 * i + 1] = xa.y; xq[4 * i + 2] = xa.z; xq[4 * i + 3] = xa.w; }
}
__device__ __forceinline__ void p5_payb(unsigned (&ac)[8], size_t t, int lane, const float* __restrict__ act) {
    const int eg = lane >> 3; const unsigned ob = ((unsigned)t * 64u + (unsigned)(eg * 8)) << 2; const u32x4 a = *(const u32x4*)((const char*)act + ob), b = *(const u32x4*)((const char*)act + ob + 16u);
    ac[0] = a.x; ac[1] = a.y; ac[2] = a.z; ac[3] = a.w; ac[4] = b.x; ac[5] = b.y; ac[6] = b.z; ac[7] = b.w;
}
template <int H, int RSH = 10> __device__ __forceinline__ void p5_gather8(u32x4 (&u)[8], const unsigned (&e)[8], int sl, int lane, const unsigned char* __restrict__ TB) {
    const unsigned base = (unsigned)(128 * sl + 16 * (lane & 7));
#pragma unroll
    for (int i = 0; i < 4; ++i) { const unsigned w = e[4 * H + i];
        u[2 * i] = *(const u32x4*)(TB + (((w & 0xffffu) << RSH) + base)); u[2 * i + 1] = *(const u32x4*)(TB + (((w >> 16) << RSH) + base)); }
}
__device__ __forceinline__ void p5a_finish(float (&p)[16], size_t t, int sl, int lane, float* __restrict__ part) {
    { const bool hi = lane & 4;
#pragma unroll
      for (int i = 0; i < 8; ++i) { const float snd = hi ? p[i] : p[i + 8], kp = hi ? p[i + 8] : p[i]; p[i] = kp + __shfl_xor(snd, 4); } }
    { const bool hi = lane & 2;
#pragma unroll
      for (int i = 0; i < 4; ++i) { const float snd = hi ? p[i] : p[i + 4], kp = hi ? p[i + 4] : p[i]; p[i] = kp + __shfl_xor(snd, 2); } }
    { const bool hi = lane & 1;
#pragma unroll
      for (int i = 0; i < 2; ++i) { const float snd = hi ? p[i] : p[i + 2], kp = hi ? p[i + 2] : p[i]; p[i] = kp + __shfl_xor(snd, 1); } }
    *(unsigned*)((char*)part + ((((unsigned)t * 4u + (unsigned)sl) * 64u + (unsigned)lane) << 2)) = pk2(p[0], p[1]);
}
__device__ __forceinline__ void p5act_token(size_t t, int lane, const float* __restrict__ ss2, const float* __restrict__ part, const float* __restrict__ gate, float* __restrict__ act) {
    const float rs = 0.5f / (U8_SCALE * X8_SCALE);
    f32x2 a = {0.f, 0.f};
#pragma unroll
    for (int sl = 0; sl < 4; ++sl) { const unsigned w = ((const unsigned*)part)[(t * 4 + sl) * 64 + lane]; a[0] += __uint_as_float(w << 16); a[1] += __uint_as_float(w & 0xffff0000u); }
    const f32x2 g = *(const f32x2*)(gate + t * 128 + 2 * lane);
    const float a0 = a[0] * rs, a1 = a[1] * rs;
    float r0 = clamp6(0.5f * a0 * (1.0f + erff(a0 * 0.70710678118654752f)) * g[0]), r1 = clamp6(0.5f * a1 * (1.0f + erff(a1 * 0.70710678118654752f)) * g[1]);
    const int q = lane >> 3; unsigned char* ob = (unsigned char*)act + t * 256 + 8 * (lane & 7) + (q >> 1) + 4 * (q & 1);
#pragma unroll
    for (int r = 0; r < 4; ++r) {
        const unsigned w = (unsigned)__builtin_amdgcn_cvt_scalef32_pk_fp4_f32(0u, r0, r1, 1.0f, 0) & 0xffu;
        const f32x2 back = __builtin_amdgcn_cvt_scalef32_pk_f32_fp4(w, 1.0f, 0);
        const float m = r == 0 ? 4.0f : 8.0f; r0 = (r0 - back[0]) * m; r1 = (r1 - back[1]) * m;
        const unsigned xb = (unsigned)__shfl_xor((int)w, 8);
        const unsigned o = (q & 1) ? (((xb >> 4) & 15u) | (w & 0xf0u)) : ((w & 15u) | ((xb & 15u) << 4));
        ob[64 * r] = (unsigned char)o; }
}
__device__ __forceinline__ void p5b_finish(h16x2 (&y)[16], size_t t, int sl, int lane, float* __restrict__ out, const bf16_t* __restrict__ xb2) {
    const int m = lane & 7, eg = lane >> 3;
    { const bool hi = lane & 32;
#pragma unroll
      for (int i = 0; i < 8; ++i) { const h16x2 snd = hi ? y[i] : y[i + 8], kp = hi ? y[i + 8] : y[i]; y[i] = kp + shfl_h2(snd, 32); } }
    { const bool hi = lane & 16;
#pragma unroll
      for (int i = 0; i < 4; ++i) { const h16x2 snd = hi ? y[i] : y[i + 4], kp = hi ? y[i + 4] : y[i]; y[i] = kp + shfl_h2(snd, 16); } }
    { const bool hi = lane & 8;
#pragma unroll
      for (int i = 0; i < 2; ++i) { const h16x2 snd = hi ? y[i] : y[i + 2], kp = hi ? y[i + 2] : y[i]; y[i] = kp + shfl_h2(snd, 8); } }
    const unsigned oc = (unsigned)t * 1024u + (unsigned)(256 * sl + 32 * m + 4 * eg);
    const u32x2 xw = *(const u32x2*)((const char*)xb2 + (oc << 1));
    const f32x2 y0 = __builtin_convertvector(y[0], f32x2), y1 = __builtin_convertvector(y[1], f32x2);
    *(f32x4*)((char*)out + (oc << 2)) = (f32x4){__uint_as_float(xw.x << 16) + y0[0], __uint_as_float(xw.x & 0xffff0000u) + y0[1], __uint_as_float(xw.y << 16) + y1[0], __uint_as_float(xw.y & 0xffff0000u) + y1[1]};
}
template <int PHASE> struct P5Ch { static constexpr int CH = 16, NCH = T / CH; };
constexpr int CW_CNTA = 8192, CW_CNTB = 8192 + 1024;
__device__ __forceinline__ void xq_token(size_t t, int lane, const float* __restrict__ ss2, const bf16_t* __restrict__ xb2, unsigned char* __restrict__ XQ) {
    float ssum = lane < 16 ? ss2[t * 16 + lane] : 0.f; ssum = wave_sum(ssum);
    const float rq = X8_SCALE / sqrtf(ssum * (1.0f / D) + EPS);
    const unsigned ob = ((unsigned)t * 1024u + 16u * (unsigned)lane) << 1;
    const u32x4 r0 = *(const u32x4*)((const char*)xb2 + ob), r1 = *(const u32x4*)((const char*)xb2 + ob + 16u);
    const unsigned w[8] = {r0.x, r0.y, r0.z, r0.w, r1.x, r1.y, r1.z, r1.w};
    unsigned hh[2] = {0u, 0u}, ll[2] = {0u, 0u};
#pragma unroll
    for (int k = 0; k < 16; ++k) { const float xv = (k & 1) ? __uint_as_float(w[k >> 1] & 0xffff0000u) : __uint_as_float(w[k >> 1] << 16);
        int x8 = (int)rintf(xv * rq); x8 = x8 < -120 ? -120 : x8 > 119 ? 119 : x8;
        const int xh = (x8 + 8) >> 4, xl = x8 - 16 * xh;
        hh[k >> 3] |= (unsigned)(xh & 15) << (4 * (k & 7)); ll[k >> 3] |= (unsigned)(xl & 15) << (4 * (k & 7)); }
    unsigned char* o = XQ + (size_t)t * 1024 + 32 * (lane >> 1) + 8 * (lane & 1);
    *(u32x2*)o = (u32x2){hh[0], hh[1]}; *(u32x2*)(o + 16) = (u32x2){ll[0], ll[1]};
}
__device__ __forceinline__ void p5_payq(u32x4 (&xq)[2], size_t t, int sl, int lane, const unsigned char* __restrict__ XQ) {
    const unsigned ob = (unsigned)t * 1024u + (unsigned)(32 * (8 * sl + (lane & 7)));
    xq[0] = *(const u32x4*)(XQ + ob); xq[1] = *(const u32x4*)(XQ + ob + 16u);
}
__device__ __forceinline__ float dot32_i4(const u32x4 u, const u32x4 (&xq)[2], int s2) {
    int h = 0, l = 0;
    h = __builtin_amdgcn_sdot8((int)u.x, (int)xq[0].x, h, false); l = __builtin_amdgcn_sdot8((int)u.x, (int)xq[1].x, l, false);
    h = __builtin_amdgcn_sdot8((int)u.y, (int)xq[0].y, h, false); l = __builtin_amdgcn_sdot8((int)u.y, (int)xq[1].y, l, false);
    h = __builtin_amdgcn_sdot8((int)u.z, (int)xq[0].z, h, false); l = __builtin_amdgcn_sdot8((int)u.z, (int)xq[1].z, l, false);
    h = __builtin_amdgcn_sdot8((int)u.w, (int)xq[0].w, h, false); l = __builtin_amdgcn_sdot8((int)u.w, (int)xq[1].w, l, false);
    return (float)(2 * (16 * h + l) + s2);
}
__device__ __forceinline__ int sum32_i4(const u32x4 (&xq)[2]) {
    int h = 0, l = 0;
    h = __builtin_amdgcn_sdot8(0x11111111, (int)xq[0].x, h, false); h = __builtin_amdgcn_sdot8(0x11111111, (int)xq[0].y, h, false); h = __builtin_amdgcn_sdot8(0x11111111, (int)xq[0].z, h, false); h = __builtin_amdgcn_sdot8(0x11111111, (int)xq[0].w, h, false);
    l = __builtin_amdgcn_sdot8(0x11111111, (int)xq[1].x, l, false); l = __builtin_amdgcn_sdot8(0x11111111, (int)xq[1].y, l, false); l = __builtin_amdgcn_sdot8(0x11111111, (int)xq[1].z, l, false); l = __builtin_amdgcn_sdot8(0x11111111, (int)xq[1].w, l, false);
    return 16 * h + l;
}
__device__ __forceinline__ void p5_item_a(size_t t0, int sl, int lane, const unsigned char* __restrict__ XQ, const int* __restrict__ idx, const unsigned char* __restrict__ U8, float* __restrict__ part) {
    unsigned eC[8], eN[8]; u32x4 xC[2], xN[2]; u32x4 gA[8], gB[8];
    p5_ids(eC, t0, lane, idx); p5_payq(xC, t0, sl, lane, XQ); p5_gather8<0, 9>(gA, eC, sl, lane, U8);
    p5_ids(eN, t0 + 1, lane, idx); p5_payq(xN, t0 + 1, sl, lane, XQ);
#pragma unroll 1
    for (int tt = 0; tt < P5Ch<0>::CH; ++tt) {
        const size_t t = t0 + tt, tn2 = t0 + (tt + 2 < P5Ch<0>::CH ? tt + 2 : P5Ch<0>::CH - 1);
        p5_gather8<1, 9>(gB, eC, sl, lane, U8);
        const int s2 = sum32_i4(xC);
        float p[16];
#pragma unroll
        for (int i = 0; i < 8; ++i) p[i] = dot32_i4(gA[i], xC, s2);
        p5_gather8<0, 9>(gA, eN, sl, lane, U8);
#pragma unroll
        for (int i = 0; i < 8; ++i) p[8 + i] = dot32_i4(gB[i], xC, s2);
#pragma unroll
        for (int i = 0; i < 8; ++i) eC[i] = eN[i];
        xC[0] = xN[0]; xC[1] = xN[1];
        p5_ids(eN, tn2, lane, idx); p5_payq(xN, tn2, sl, lane, XQ);
        p5a_finish(p, t, sl, lane, part);
    }
}
__device__ __forceinline__ void fma8rows(h16x2 (&y)[16], const u32x4 (&v)[8], const unsigned (&ac)[8], int h) {
#pragma unroll
    for (int i = 0; i < 4; ++i) { const unsigned w = h ? ac[4 + i] : ac[i]; fma32_fp4h(y, v[2 * i], bc_h2(__uint_as_float(w << 16))); fma32_fp4h(y, v[2 * i + 1], bc_h2(__uint_as_float(w & 0xffff0000u))); }
}
typedef int i32x2 __attribute__((ext_vector_type(2)));
typedef int i32x8 __attribute__((ext_vector_type(8)));
__device__ __forceinline__ void p5b_dma(LAS unsigned char* lb, const unsigned (&e)[8], int sl, int lane, const unsigned char* __restrict__ V4) {
    const int q = lane >> 3, p = lane & 7;
#pragma unroll
    for (int k = 0; k < 16; ++k) { const unsigned w = e[k >> 1]; const unsigned id = (k & 1) ? (w >> 16) : (w & 0xffffu);
        const int f = (4 * (k & 1) + (q >> 1)) & 7;
        const unsigned off = (id << 9) + (unsigned)(128 * sl + 16 * (p ^ f));
        __builtin_amdgcn_global_load_lds((const unsigned*)(V4 + off), (LAS unsigned*)(lb + k * 1024), 16, 0, 0); }
}
struct ActIn { unsigned pw[4]; f32x2 g; };
__device__ __forceinline__ void p5b_act_load(ActIn& ai, size_t t, int lane, const float* __restrict__ part, const float* __restrict__ gate) {
#pragma unroll
    for (int s_ = 0; s_ < 4; ++s_) ai.pw[s_] = ((const unsigned*)part)[((unsigned)t * 4u + (unsigned)s_) * 64u + (unsigned)lane];
    ai.g = *(const f32x2*)(gate + ((unsigned)t * 128u + 2u * (unsigned)lane));
}
__device__ __forceinline__ void p5b_act_planes(const ActIn& ai, int lane, LAS unsigned char* pl) {
    const float rs = 0.5f / (U8_SCALE * X8_SCALE);
    float a0 = 0.f, a1 = 0.f;
#pragma unroll
    for (int s_ = 0; s_ < 4; ++s_) { a0 += __uint_as_float(ai.pw[s_] << 16); a1 += __uint_as_float(ai.pw[s_] & 0xffff0000u); }
    a0 *= rs; a1 *= rs;
    float r0 = clamp6(0.5f * a0 * (1.0f + erff(a0 * 0.70710678118654752f)) * ai.g[0]), r1 = clamp6(0.5f * a1 * (1.0f + erff(a1 * 0.70710678118654752f)) * ai.g[1]);
    const int q = lane >> 3; LAS unsigned char* ob = pl + 8 * (lane & 7) + (q >> 1) + 4 * (q & 1);
#pragma unroll
    for (int r = 0; r < 4; ++r) {
        const unsigned w = (unsigned)__builtin_amdgcn_cvt_scalef32_pk_fp4_f32(0u, r0, r1, 1.0f, 0) & 0xffu;
        const f32x2 back = __builtin_amdgcn_cvt_scalef32_pk_f32_fp4(w, 1.0f, 0);
        const float m = r == 0 ? 4.0f : 8.0f; r0 = (r0 - back[0]) * m; r1 = (r1 - back[1]) * m;
        const unsigned xb = (unsigned)__shfl_xor((int)w, 8);
        const unsigned o = (q & 1) ? (((xb >> 4) & 15u) | (w & 0xf0u)) : ((w & 15u) | ((xb & 15u) << 4));
        ob[64 * r] = (unsigned char)o; }
}
__device__ __forceinline__ void p5b_x2(unsigned (&x)[4], size_t t, int sl, int lane, const bf16_t* __restrict__ xb2) {
    const unsigned oc = (unsigned)t * 1024u + (unsigned)(256 * sl + 64 * (lane >> 4) + (lane & 15));
#pragma unroll
    for (int m = 0; m < 4; ++m) x[m] = *(const unsigned short*)((const char*)xb2 + ((oc + 16u * m) << 1));
}
__device__ __forceinline__ void p5b_store(const float (&y)[4], const unsigned (&x)[4], size_t t, int sl, int lane, float* __restrict__ out) {
    const unsigned oc = (unsigned)t * 1024u + (unsigned)(256 * sl + 64 * (lane >> 4) + (lane & 15));
#pragma unroll
    for (int m = 0; m < 4; ++m) *(float*)((char*)out + ((oc + 16u * m) << 2)) = __uint_as_float(x[m] << 16) + y[m] * (1.0f / V4_SCALE);
}
__device__ __forceinline__ void p5_item_b(size_t t0, int sl, int lane, LAS unsigned char* lb, LAS unsigned char* pl, float* __restrict__ out, const bf16_t* __restrict__ xb2, const int* __restrict__ idx, const unsigned char* __restrict__ V4,
                                          const float* __restrict__ part, const float* __restrict__ gate) {
    constexpr int CH = P5Ch<1>::CH;
    unsigned eN[8]; u32x4 aC; ActIn ai; unsigned xC[4], xN[4]; float yP[4] = {0.f, 0.f, 0.f, 0.f};
    const int sa = (lane & 3) == 0 ? 0x7f7f7f7f : (lane & 3) == 1 ? 0x7d7d7d7d : (lane & 3) == 2 ? 0x7a7a7a7a : 0x77777777;
    p5_ids(eN, t0, lane, idx); p5b_act_load(ai, t0, lane, part, gate); p5b_x2(xN, t0, sl, lane, xb2);
    p5b_dma(lb, eN, sl, lane, V4);
    p5_ids(eN, t0 + 1, lane, idx);
    p5b_act_planes(ai, lane, pl);
#pragma unroll 1
    for (int tt = 0; tt < CH; ++tt) {
        const size_t t = t0 + tt, tn1 = t0 + (tt + 1 < CH ? tt + 1 : CH - 1), tn2 = t0 + (tt + 2 < CH ? tt + 2 : CH - 1);
        int ln = lane; asm volatile("" : "+v"(ln));
        const int j = ln & 15, g = ln >> 4;
        asm volatile("s_waitcnt vmcnt(0)" ::: "memory");
        if (tt > 0) p5b_store(yP, xC, t - 1, sl, ln, out);
        aC = *(const LAS u32x4*)(pl + 64 * (ln & 3) + 16 * g);
#pragma unroll
        for (int m = 0; m < 4; ++m) xC[m] = xN[m];
        i32x2 b[32];
        { const LAS unsigned char* rb = lb + (32 * g + j) * 128; const int fj = 16 * ((j >> 1) & 7);
#pragma unroll
          for (int c = 0; c < 8; ++c) { const LAS unsigned char* pc = rb + ((16 * c) ^ fj);
              b[4 * c] = __builtin_amdgcn_ds_read_tr4_b64_v2i32((LAS i32x2*)pc); b[4 * c + 1] = __builtin_amdgcn_ds_read_tr4_b64_v2i32((LAS i32x2*)(pc + 2048));
              b[4 * c + 2] = __builtin_amdgcn_ds_read_tr4_b64_v2i32((LAS i32x2*)(pc + 8)); b[4 * c + 3] = __builtin_amdgcn_ds_read_tr4_b64_v2i32((LAS i32x2*)(pc + 8 + 2048)); } }
        asm volatile("s_waitcnt lgkmcnt(0)" ::: "memory");
        p5b_act_load(ai, tn1, ln, part, gate); p5b_x2(xN, tn1, sl, ln, xb2);
        { unsigned eT[8];
#pragma unroll
          for (int i = 0; i < 8; ++i) eT[i] = eN[i];
          p5_ids(eN, tn2, ln, idx);
          if (tt + 1 < CH) p5b_dma(lb, eT, sl, ln, V4); }
        float y[16];
        { const i32x8 A = {(int)aC.x, (int)aC.y, (int)aC.z, (int)aC.w, 0, 0, 0, 0}; const f32x4 z = {0.f, 0.f, 0.f, 0.f};
#pragma unroll
          for (int n = 0; n < 16; ++n) { const i32x8 B = {b[2 * n][0], b[2 * n][1], b[2 * n + 1][0], b[2 * n + 1][1], 0, 0, 0, 0};
              const f32x4 c = __builtin_amdgcn_mfma_scale_f32_16x16x128_f8f6f4(A, B, z, 4, 4, 0, sa, 0, 0x7f7f7f7f);
              float v = (c[0] + c[1]) + (c[2] + c[3]); asm volatile("" : "+v"(v)); y[n] = v; } }
#pragma unroll
        for (int m = 0; m < 4; ++m) yP[m] = g == 0 ? y[m] : g == 1 ? y[4 + m] : g == 2 ? y[8 + m] : y[12 + m];
        p5b_act_planes(ai, ln, pl);
    }
    asm volatile("s_waitcnt vmcnt(0)" ::: "memory");
    p5b_store(yP, xN, t0 + CH - 1, sl, lane, out);
}
template <int PHASE> __device__ __forceinline__ void p5_sliced(unsigned* cnt, int lane, float* __restrict__ out, const bf16_t* __restrict__ xb2, const unsigned char* __restrict__ XQ, const int* __restrict__ idx, const unsigned char* __restrict__ TB, float* __restrict__ buf, LAS unsigned char* lb, LAS unsigned char* pl, const float* __restrict__ gate) {
    const unsigned xcc = (unsigned)__builtin_amdgcn_s_getreg((3 << 11) | 20) & 7u;
    constexpr int NSL = 4;
    for (int tr = 0; tr < NSL; ++tr) { const int sl = (int)((xcc + tr) & (unsigned)(NSL - 1));
        for (;;) { unsigned c = 0; if (lane == 0) c = __hip_atomic_fetch_add(cnt + 64 * sl, 1u, __ATOMIC_RELAXED, __HIP_MEMORY_SCOPE_AGENT);
            c = (unsigned)__builtin_amdgcn_readfirstlane((int)c); if (c >= (unsigned)P5Ch<PHASE>::NCH) break;
            if (PHASE == 0) p5_item_a((size_t)c * P5Ch<0>::CH, sl, lane, XQ, idx, TB, buf); else p5_item_b((size_t)c * P5Ch<1>::CH, sl, lane, lb, pl, out, xb2, idx, TB, buf, gate); } }
}

#define XB_TMO      128
#define XB_XCNT(j)  (256  + 64 * (j))
#define XB_XSUB(j)  (1280 + 64 * (j))
#define XB_XGEN(j)  (2304 + 64 * (j))
#define XB_TOP      3328
#define XB_TOPGEN   3392
#define XCD_BAR_WORDS 3456
#define XB_SPIN_CAP (1u << 18)

__device__ __forceinline__ unsigned xb_ld(unsigned* p)              { return __hip_atomic_load(p, __ATOMIC_RELAXED, __HIP_MEMORY_SCOPE_AGENT); }
__device__ __forceinline__ unsigned xb_add(unsigned* p, unsigned v) { return __hip_atomic_fetch_add(p, v, __ATOMIC_RELAXED, __HIP_MEMORY_SCOPE_AGENT); }
__device__ __forceinline__ unsigned xb_xcc_id() { return (unsigned)__builtin_amdgcn_s_getreg((3 << 11) | 20) & 0xFu; }
#define XB_SPIN(cond, bar) do { unsigned _sp = 0; while (cond) { __builtin_amdgcn_s_sleep(1); \
    if ((++_sp & 255u) == 0u) { if (xb_ld(&(bar)[XB_TMO])) break; if (_sp > XB_SPIN_CAP) { atomicAdd(&(bar)[XB_TMO], 1u); break; } } } } while (0)

struct XcdBarrier {
    unsigned* bar; unsigned x;
    volatile LAS unsigned* st;
};

__device__ __forceinline__ XcdBarrier xcd_barrier_post(unsigned* bar, volatile LAS unsigned* st, int tid) {
    XcdBarrier b; b.bar = bar; b.x = xb_xcc_id(); b.st = st;
    if (tid == 0) (void)xb_add(&bar[XB_XCNT(b.x)], 1u);
    return b;
}
__device__ __forceinline__ void xcd_barrier_complete(unsigned* bar, unsigned x, unsigned& nloc, unsigned& nx) {
    const unsigned G = gridDim.x * gridDim.y * gridDim.z;
    unsigned sum, cnt, mine, sp = 0u;
    for (;;) {
        sum = 0u; cnt = 0u; mine = 0u;
#pragma unroll
        for (unsigned j = 0; j < 16; ++j) { const unsigned c = xb_ld(&bar[XB_XCNT(j)]); sum += c; cnt += (c > 0u) ? 1u : 0u; mine = (j == x) ? c : mine; }
        if (sum == G) break;
        __builtin_amdgcn_s_sleep(1);
        if ((++sp & 255u) == 0u) { if (xb_ld(&bar[XB_TMO])) break; if (sp > XB_SPIN_CAP) { atomicAdd(&bar[XB_TMO], 1u); break; } }
    }
    nloc = mine > 0u ? mine : 1u; nx = cnt > 0u ? cnt : 1u;
}

__device__ __forceinline__ void xcd_barrier(const XcdBarrier& b, int tid) {
    asm volatile("s_waitcnt vmcnt(0)" ::: "memory");
    __syncthreads();
    if (tid == 0) {
        unsigned* bar = b.bar;
        __builtin_amdgcn_s_waitcnt(0);
        unsigned nloc = b.st[0], nx = b.st[1];
        if (nloc == 0u) { xcd_barrier_complete(bar, b.x, nloc, nx); b.st[0] = nloc; b.st[1] = nx; }
        const unsigned old = xb_add(&bar[XB_XSUB(b.x)], 1u);
        const unsigned gen = old / nloc;
        if (old + 1u == (gen + 1u) * nloc) {
            __builtin_amdgcn_fence(__ATOMIC_RELEASE, "agent");
            asm volatile("s_waitcnt vmcnt(0)" ::: "memory");
            const unsigned og = xb_add(&bar[XB_TOP], 1u);
            const unsigned tg = og / nx;
            if (og + 1u == (tg + 1u) * nx) xb_add(&bar[XB_TOPGEN], 1u);
            else XB_SPIN(xb_ld(&bar[XB_TOPGEN]) == tg, bar);
            __builtin_amdgcn_fence(__ATOMIC_ACQUIRE, "agent");
            xb_add(&bar[XB_XGEN(b.x)], 1u);
            asm volatile("s_waitcnt vmcnt(0)" ::: "memory");
        } else {
            XB_SPIN(xb_ld(&bar[XB_XGEN(b.x)]) == gen, bar);
            __builtin_amdgcn_fence(__ATOMIC_ACQUIRE, "agent");
            asm volatile("s_waitcnt vmcnt(0)" ::: "memory");
        }
    }
    __syncthreads();
}

#ifndef REP_P0
#define REP_P0 1
#endif
#ifndef REP_P1
#define REP_P1 1
#endif
#ifndef REP_ATT
#define REP_ATT 1
#endif
#ifndef REP_POOL
#define REP_POOL 1
#endif
#ifndef REP_P3
#define REP_P3 1
#endif
#ifndef REP_P4
#define REP_P4 1
#endif
#ifndef REP_P5A
#define REP_P5A 1
#endif
#ifndef REP_P5ACT
#define REP_P5ACT 1
#endif
#ifndef REP_SYNC
#define REP_SYNC 1
#endif
__global__ void __launch_bounds__(NTHREADS, 2) mk_fwd(Args a) {
    extern __shared__ __attribute__((aligned(16))) unsigned char lds[];
    const int G = gridDim.x, bid = blockIdx.x, NGW = G * NWAVES;
    int tid, lane, wave, gw;
    int wave_s; { const int w_ = (int)(threadIdx.x >> 6); asm volatile("s_nop 1\n\tv_readfirstlane_b32 %0, %1\n\ts_nop 3" : "=s"(wave_s) : "v"(w_)); }
#define REFRESH_IDS() do { int l_; asm volatile("v_mbcnt_lo_u32_b32 %0, -1, 0\n\tv_mbcnt_hi_u32_b32 %0, -1, %0" : "=&v"(l_)); lane = l_; wave = wave_s; tid = wave_s * 64 + l_; gw = bid * NWAVES + wave; } while (0)
    REFRESH_IDS();
    { volatile LAS unsigned* st = (volatile LAS unsigned*)((LAS unsigned char*)lds + MISC_OFF); if (tid < 2) st[tid] = 0u; }
    __syncthreads();
    const XcdBarrier xbar = xcd_barrier_post((unsigned*)(a.ws + WS_CTL) + CW_BAR, (volatile LAS unsigned*)((LAS unsigned char*)lds + MISC_OFF), tid);
#define GRID_BAR() do { xcd_barrier(xbar, tid); REFRESH_IDS(); } while (0)
    const float* x = a.in[0]; const float* g1 = a.in[1]; const float* w_in = a.in[2];
    const float* qg = a.in[3]; const float* kg = a.in[4]; const float* pool_w = a.in[5]; const float* pool_scale = a.in[6];
    const float* w_out = a.in[7]; const float* g2 = a.in[8]; const float* wq = a.in[9]; const float* sk = a.in[10];
    const float* pu = a.in[11]; const float* pv = a.in[12];
    unsigned char* ws = a.ws; float* out = a.out;
    float* rs1 = (float*)(ws + WS_RS1); float* ss2 = (float*)(ws + WS_SS2); float2* rope = (float2*)(ws + WS_ROPE); unsigned char* XQ = ws + WS_P;
    bf16_t* xb = (bf16_t*)(ws + WS_XB); bf16_t* Q = (bf16_t*)(ws + WS_Q); bf16_t* Kb = (bf16_t*)(ws + WS_K); bf16_t* V = (bf16_t*)(ws + WS_V); bf16_t* P = (bf16_t*)(ws + WS_P);
    bf16_t* mix = (bf16_t*)(ws + WS_MIX); bf16_t* xb2 = (bf16_t*)(ws + WS_XB2);
    int* idx = (int*)(ws + WS_IDX); float* gate = (float*)(ws + WS_GATE);
    bf16_t* WinT = (bf16_t*)(ws + WS_WIN); bf16_t* WoutT = (bf16_t*)(ws + WS_WOUT); bf16_t* WscT = (bf16_t*)(ws + WS_WSC);
    unsigned char* U8 = ws + WS_U16; unsigned char* V8 = ws + WS_V16;
    LAS unsigned char* ldsp = (LAS unsigned char*)lds;

    for (int rep0 = 0; rep0 < REP_P0; ++rep0) {
    for (int e = bid * NTHREADS + tid; e < S * 32; e += G * NTHREADS) {
        const int pos = e >> 5, j = e & 31; const double f = pow(10000.0, -(double)(2 * j) / 64.0); const double ang = (double)pos * f;
        rope[e] = make_float2((float)cos(ang), (float)sin(ang)); }
    for (int row = gw; row < T; row += NGW) {
        const float4* xr = (const float4*)(x + (size_t)row * D); float4 v[4]; float ss = 0.f;
#pragma unroll
        for (int j = 0; j < 4; ++j) { v[j] = xr[lane + 64 * j]; ss += v[j].x * v[j].x + v[j].y * v[j].y + v[j].z * v[j].z + v[j].w * v[j].w; }
        ss = wave_sum(ss);
        if (lane == 0) rs1[row] = 1.0f / sqrtf(ss * (1.0f / D) + EPS);
        uint2* o = (uint2*)(xb + (size_t)row * D);
#pragma unroll
        for (int j = 0; j < 4; ++j) o[lane + 64 * j] = make_uint2(f2bf(v[j].x) | (f2bf(v[j].y) << 16), f2bf(v[j].z) | (f2bf(v[j].w) << 16)); }
    {
        LAS float* scr = (LAS float*)(ldsp + wave * 16384);
        for (int it = gw; it < 1024 + 256; it += NGW) {
            if (it < 1024) { const int kb = it >> 6, nb = it & 63; p0_transpose_item(w_in, 2048, win_src_col(32 * nb), g1, WinT, 1024, 64 * kb, 32 * nb, scr, lane); }
            else { const int r = it - 1024, kb = r >> 5, nb = r & 31; p0_transpose_item(w_out, 1024, 32 * nb, nullptr, WoutT, 1024, 64 * kb, 32 * nb, scr, lane); }
        }
    }
    __syncthreads();
    for (int item = G - 1 - bid; item < 64; item += G) p0_poolfold_item(item, tid, (LAS float*)ldsp, w_out, pool_w, pool_scale, WoutT);
    for (int item = bid; item < 256; item += G) p0_wprime_item(item, tid, (LAS float*)ldsp, wq, sk, g2, WscT);
    __syncthreads(); }
    GRID_BAR();
    { pg8::Gemm g{xb, WinT, T, 2048, 1024}; pg8::StaticOrder So; So.init(T, 2048, G, bid);
      EpiProj E{rs1, qg, kg, rope, Q, Kb, V, P};
      for (int rep = 0; rep < REP_P1; ++rep) { pg8::gemm_phase<EpiProj, pg8::StaticOrder, true, true>(ldsp, g, So, E, tid); __syncthreads(); } }
    GRID_BAR();
    for (int rep = 0; rep < REP_ATT; ++rep)
    { const int per = (1024 + G - 1) / G;
      for (int j = 0; j < per; ++j) { const int bt = bid * per + j; if (bt >= 1024) break;
          const int pl_ = (G == 256) ? (8 * j + (bid & 7)) : (bt >> 5), sp_ = (G == 256) ? (bid >> 3) : (bt & 31); const int b_ = pl_ >> 3, h_ = pl_ & 7;
          attn_stage(ldsp, Kb, V, (size_t)(b_ * 8 + h_) * 8192 * 64, sp_, wave, lane);
          asm volatile("s_waitcnt vmcnt(0)" ::: "memory"); __syncthreads();
          { const int r0_ = rep == 0 ? (bt * 8 + wave) * 2 : -1;
            attn_task(b_, h_, sp_, wave, lane, ldsp, Q, Kb, V, mix, r0_, pu, pv, g2, U8, V8); attn_task(b_, h_, sp_, wave + 8, lane, ldsp, Q, Kb, V, mix, r0_ < 0 ? -1 : r0_ + 1, pu, pv, g2, U8, V8); }
          __syncthreads(); } }
    for (int rep = 0; rep < REP_POOL; ++rep)
    for (int wt = gw; wt < 32768; wt += NGW) { const int g_ = wt & 3, tq_ = wt >> 2;
        if (g_ == 0) pooled_task<2>(tq_, 0, lane, P, mix); else if (g_ == 1) pooled_task<4>(tq_, 1, lane, P, mix); else if (g_ == 2) pooled_task<8>(tq_, 2, lane, P, mix); else pooled_task<16>(tq_, 3, lane, P, mix); }
    GRID_BAR();
    { pg8::Gemm g{mix, WoutT, T, 1024, 1024}; pg8::StaticOrder So; So.init(T, 1024, G, bid);
      EpiOut E{xb, out, xb2, ss2};
      for (int rep = 0; rep < REP_P3; ++rep) { pg8::gemm_phase<EpiOut, pg8::StaticOrder, true, true>(ldsp, g, So, E, tid); __syncthreads(); } }
    GRID_BAR();
    for (int t = gw; t < T; t += NGW) xq_token((size_t)t, lane, ss2, xb2, XQ);
    { pg8::StaticOrder So; So.init(T, 2048, G, bid); pg8::Gemm g{xb2, WscT, T, 2048, 1024}; EpiScores E{ss2, idx, gate};
      for (int rep = 0; rep < REP_P4; ++rep)
      for (int i = 0;; ++i) { SingleUnit Su; if (!So.next(i, Su.u)) break;
          pg8::gemm_phase<EpiScores, SingleUnit, false, true>(ldsp, g, Su, E, tid); __syncthreads(); } }
    GRID_BAR();
    for (int rep = 1; rep < REP_SYNC; ++rep) { GRID_BAR(); }
    { float* part = (float*)(ws + WS_XB); float* actb = (float*)(ws + WS_V); unsigned* ctl = (unsigned*)(ws + WS_CTL);
      for (int rep = 0; rep < REP_P5A; ++rep) p5_sliced<0>(ctl + CW_CNTA + 2048 * rep, lane, out, xb2, XQ, idx, U8, part, ldsp + wave * 16384, ldsp + 131072 + wave * 1024, gate);
      GRID_BAR();
      p5_sliced<1>(ctl + CW_CNTB, lane, out, xb2, XQ, idx, V8, part, ldsp + wave * 16384, ldsp + 131072 + wave * 1024, gate); }
}

extern "C" void kernel_launch(void* const* d_in, const int* in_sizes, int n_in, void* d_out, int out_size, void* d_ws, size_t ws_size, hipStream_t stream) {
    static int grid_blocks = 0;
    if (grid_blocks == 0) {
        if (n_in != 13 || in_sizes[0] != T * D || out_size != T * D || ws_size < WS_END) { fprintf(stderr, "kernel_launch: unexpected shapes (n_in %d, in0 %d, out %d, ws %zu)\n", n_in, n_in > 0 ? in_sizes[0] : -1, out_size, ws_size); grid_blocks = -1; return; }
        int dev = 0, cus = 0, per_cu = 0;
        hipGetDevice(&dev); hipDeviceGetAttribute(&cus, hipDeviceAttributeMultiprocessorCount, dev);
        hipFuncSetAttribute((const void*)mk_fwd, hipFuncAttributeMaxDynamicSharedMemorySize, LDS_BYTES);
        hipOccupancyMaxActiveBlocksPerMultiprocessor(&per_cu, (const void*)mk_fwd, NTHREADS, LDS_BYTES);
        if (per_cu < 1) { fprintf(stderr, "kernel_launch: occupancy query says %d blocks per CU\n", per_cu); per_cu = 1; }
        if (per_cu > 1) per_cu = 1;
        grid_blocks = cus * per_cu;
        fprintf(stderr, "kernel_launch: %d CUs x %d = grid %d\n", cus, per_cu, grid_blocks);
    }
    if (grid_blocks < 0) return;
    if (hipMemsetAsync((char*)d_ws + WS_CTL, 0, CTL_ZERO_BYTES, stream) != hipSuccess) { fprintf(stderr, "kernel_launch: memset of the control words failed\n"); return; }
    Args a{};
    for (int i = 0; i < 13; ++i) a.in[i] = (const float*)d_in[i];
    a.out = (float*)d_out; a.ws = (unsigned char*)d_ws;
    void* args[] = {&a};
    hipError_t e = hipLaunchCooperativeKernel((const void*)mk_fwd, dim3(grid_blocks), dim3(NTHREADS), args, LDS_BYTES, stream);
    if (e != hipSuccess) fprintf(stderr, "cooperative launch failed: %s (grid %d)\n", hipGetErrorString(e), grid_blocks);
}
```

```cpp
#include <hip/hip_runtime.h>
#include <stdint.h>
#include <math.h>
#include <cstdio>

namespace cfg {
constexpr int B = 4, S = 8192, D = 1024, T = B * S;
constexpr float EPS = 1e-6f;
constexpr float QSCALE = 0.125f * 1.4426950408889634f;
}
using namespace cfg;
typedef uint16_t bf16_t;
__device__ __forceinline__ uint32_t f2bf(float f) { uint32_t u = __float_as_uint(f); return (u + 0x7fffu + ((u >> 16) & 1u)) >> 16; }
__device__ __forceinline__ float bf2f(uint32_t h) { return __uint_as_float(h << 16); }
__device__ __forceinline__ float wave_sum(float v) {
#pragma unroll
    for (int o = 1; o < 64; o <<= 1) v += __shfl_xor(v, o);
    return v;
}

constexpr size_t MiB = 1u << 20;
constexpr size_t WS_CTL = 0;
constexpr size_t WS_RS1 = 1 * MiB;
constexpr size_t WS_SS2 = 2 * MiB;
constexpr size_t WS_WIN = 4 * MiB, WS_WOUT = 8 * MiB, WS_WSC = 10 * MiB, WS_POOLW = 14 * MiB;
constexpr size_t WS_ROPE = 15 * MiB;
constexpr size_t WS_XB = 20 * MiB;
constexpr size_t WS_Q = 84 * MiB, WS_K = 116 * MiB, WS_V = 148 * MiB, WS_P = 180 * MiB;
constexpr size_t WS_MIX = 212 * MiB;
constexpr size_t WS_XB2 = 276 * MiB;
constexpr size_t WS_U16 = 340 * MiB, WS_V16 = 372 * MiB;
constexpr size_t WS_IDX = 404 * MiB, WS_GATE = 420 * MiB;
constexpr size_t WS_END = 436 * MiB;


namespace pg8 {
#define PG8_LAS __attribute__((address_space(3)))
typedef unsigned short bf16_t;
typedef short bf16x8 __attribute__((ext_vector_type(8)));
typedef float f32x4 __attribute__((ext_vector_type(4)));
typedef unsigned u32x4 __attribute__((ext_vector_type(4)));
constexpr int BM = 256, BK = 64, HALF = 128, HTB = HALF * BK * 2  , STAGE_BYTES = 8 * HTB, NXCD = 8, WGM = 8;

__host__ __device__ __forceinline__ int lds_byte(int r, int c) { const int st = (r >> 4) * 2 + (c >> 5), rr = r & 15, cc = c & 31, ob = rr * 64 + cc * 2; return st * 1024 + (ob ^ (((ob >> 9) & 1) << 5)); }
__host__ __device__ __forceinline__ void stage_rc(int b, int& R, int& C) { const int st = b / 1024, sb = b % 1024, swz = sb ^ (((sb >> 9) & 1) << 5); R = (st >> 1) * 16 + swz / 64; C = (st & 1) * 32 + (swz % 64) / 2; }
__host__ __device__ __forceinline__ int perm32(int rho) { const int n = rho >> 4, i = rho & 15; return 8 * (i >> 2) + 4 * n + (i & 3); }

struct Unit { int pm, pn; };
struct Gemm { const bf16_t* A; const bf16_t* Bt; int M, N, K; };

struct StaticOrder {
    int nM, nN, nwg, G, c;
    __host__ __device__ void init(int M, int N, int G_, int c_) { nM = M / BM; nN = N / BM; nwg = nM * nN; G = G_; c = c_; }
    __host__ __device__ bool next(int i, Unit& u) const {
        const long L = (long)i * G + c; if (L >= nwg) return false;
        int wgid = (int)L; { const int q = nwg / NXCD, r = nwg % NXCD, xcd = wgid % NXCD, off = wgid / NXCD; wgid = (xcd < r ? xcd * (q + 1) : r * (q + 1) + (xcd - r) * q) + off; }
        const int nig = WGM * nN, gid = wgid / nig, fm = gid * WGM, gsz = (nM - fm) < WGM ? (nM - fm) : WGM;
        u.pm = fm + ((wgid % nig) % gsz); u.pn = (wgid % nig) / gsz; return true;
    }
    __device__ __forceinline__ void a_ready(const Unit&) const {}
    __device__ __forceinline__ void done(const Unit&) const {}
};

__device__ __forceinline__ unsigned cvt_pk_bf16(float lo, float hi) { unsigned r; asm volatile("v_cvt_pk_bf16_f32 %0, %1, %2" : "=v"(r) : "v"(lo), "v"(hi)); return r; }
typedef float f32x2 __attribute__((ext_vector_type(2)));
__device__ __forceinline__ f32x2 gelu_pk(f32x2 v) {
    const f32x2 av = __builtin_elementwise_abs(v), d = av * 0.2316418882f + 1.0f;
    f32x2 t; t.x = __builtin_amdgcn_rcpf(d.x); t.y = __builtin_amdgcn_rcpf(d.y);
    f32x2 q = t * 0.5307027145f + (-0.7265760135f); q = q * t + 0.7107068705f; q = q * t + (-0.142248368f); q = q * t + 0.127414796f; q = q * t;
    const f32x2 s = (v * v) * (-0.72134752044f);
    f32x2 e; e.x = __builtin_amdgcn_exp2f(s.x); e.y = __builtin_amdgcn_exp2f(s.y);
    const f32x2 m = v * (q * e), r = v - m;
    f32x2 o; o.x = v.x < 0.f ? m.x : r.x; o.y = v.y < 0.f ? m.y : r.y; return o;
}

template <int ACT  > struct EpiBf16 {
    static constexpr int A_PERM_PN = 0;
    static constexpr bool PERM = true, AFTER_DRAIN = false; static_assert(ACT == 0 || ACT == 1, "EpiBf16: ACT is 0 (none) or 1 (gelu_pk)");
    bf16_t* O; int ldc; const float* bias; int split_cols; size_t split_stride; float scale0;
    __device__ __forceinline__ void operator()(const f32x4 (&acc)[2][2][4][2], const Unit& u, int wr, int wc, int fr, int fq) const {
        const int row0 = u.pm * BM + wr * 64 + fr; int colt = u.pn * BM; bf16_t* base = O;
        float sc = 1.f; if (split_cols) { const int t = colt / split_cols; base += (size_t)t * split_stride; colt -= t * split_cols; if (t == 0) sc = scale0; }
        const int col0 = colt + wc * 32 + 8 * fq, bcol0 = u.pn * BM + wc * 32 + 8 * fq;
        f32x4 bv[2][2];
#pragma unroll
        for (int bj = 0; bj < 2; ++bj)
#pragma unroll
            for (int n = 0; n < 2; ++n) bv[bj][n] = bias ? *(const f32x4*)(bias + bcol0 + bj * HALF + 4 * n) : (f32x4){0.f, 0.f, 0.f, 0.f};
#pragma unroll
        for (int ai = 0; ai < 2; ++ai)
#pragma unroll
            for (int m = 0; m < 4; ++m) { bf16_t* rowp = base + (size_t)(row0 + ai * HALF + m * 16) * ldc + col0;
#pragma unroll
                for (int bj = 0; bj < 2; ++bj) { f32x4 v0 = acc[ai][bj][m][0] + bv[bj][0], v1 = acc[ai][bj][m][1] + bv[bj][1];
                    if (ACT == 1) { f32x2 a = gelu_pk((f32x2){v0[0], v0[1]}), b = gelu_pk((f32x2){v0[2], v0[3]}), c = gelu_pk((f32x2){v1[0], v1[1]}), d = gelu_pk((f32x2){v1[2], v1[3]});
                        v0 = (f32x4){a.x, a.y, b.x, b.y}; v1 = (f32x4){c.x, c.y, d.x, d.y}; }
                    v0 = v0 * sc; v1 = v1 * sc; u32x4 w; w.x = cvt_pk_bf16(v0[0], v0[1]); w.y = cvt_pk_bf16(v0[2], v0[3]); w.z = cvt_pk_bf16(v1[0], v1[1]); w.w = cvt_pk_bf16(v1[2], v1[3]);
                    *(u32x4*)(rowp + bj * HALF) = w; } }
    }
};

template <bool PERMB> __device__ __forceinline__ void prologue_issue(PG8_LAS unsigned char* lds, const Gemm g, const Unit u, int tid) {
    const int K = g.K; const int wid = __builtin_amdgcn_readfirstlane(tid >> 6);
    unsigned voffA[2], voffB[2];
#pragma unroll
    for (int i = 0; i < 2; ++i) { int R, C; stage_rc(tid * 16 + i * 8192, R, C); const int Rb = PERMB ? ((R & ~31) + perm32(R & 31)) : R; voffA[i] = (unsigned)(R * K + C) * 2u; voffB[i] = (unsigned)(Rb * K + C) * 2u; }
    const size_t kstep = (size_t)(BK * 2), hstep = (size_t)HALF * K * 2, tstep = 2 * hstep; const unsigned ldsw = (unsigned)wid * 1024u;
    const char* cA = (const char*)g.A + (size_t)u.pm * tstep; const char* cB = (const char*)g.Bt + (size_t)u.pn * tstep;
#define PG8_PSTAGE(bufoff, gbase, voff) do { _Pragma("unroll") for (int _i = 0; _i < 2; ++_i) \
        __builtin_amdgcn_global_load_lds((const unsigned*)((const char*)(gbase) + (voff)[_i]), (PG8_LAS unsigned*)(lds + (bufoff) + ldsw + _i * 8192), 16, 0, 0); } while (0)
    PG8_PSTAGE((4 + 0) * HTB, cB, voffB); PG8_PSTAGE((4 + 1) * HTB, cB + hstep, voffB); PG8_PSTAGE(0 * HTB, cA, voffA); PG8_PSTAGE(1 * HTB, cA + hstep, voffA);
    PG8_PSTAGE((4 + 2) * HTB, cB + kstep, voffB); PG8_PSTAGE(2 * HTB, cA + kstep, voffA); PG8_PSTAGE((4 + 3) * HTB, cB + hstep + kstep, voffB);
#undef PG8_PSTAGE
}
template <class Epi, class Sched, bool ALIGN_EPI = false, bool SP2 = false, bool PRE = false>
__device__ __forceinline__ void gemm_phase(PG8_LAS unsigned char* lds, const Gemm g, const Sched& S, const Epi& E, int tid_in) {
    int tid_ = tid_in; asm volatile("" : "+v"(tid_));
    const int tid = tid_, wid = __builtin_amdgcn_readfirstlane(tid >> 6), lane = tid & 63, wr = wid >> 2, wc = wid & 3, fr = lane & 15, fq = lane >> 4;
    const int K = g.K, nt = K / BK;
    unsigned voffA[2], voffB[2];
#pragma unroll
    for (int i = 0; i < 2; ++i) { int R, C; stage_rc(tid * 16 + i * 8192, R, C); const int Rb = Epi::PERM ? ((R & ~31) + perm32(R & 31)) : R;
        voffA[i] = (unsigned)(R * K + C) * 2u; voffB[i] = (unsigned)(Rb * K + C) * 2u; }
#define PG8_AOFF(dst, mode) do { _Pragma("unroll") for (int _i = 0; _i < 2; ++_i) { int _R, _C; stage_rc(tid * 16 + _i * 8192, _R, _C); const int _m = (mode); \
        const int _Rr = _m == 1 ? 16 * (_R & 15) + (_R >> 4) : _m == 2 ? 128 * (_R >> 6) + (_R & 63) : _R; (dst)[_i] = (unsigned)(_Rr * K + _C) * 2u; } } while (0)
#define PG8_AHALF(mode) ((mode) == 1 ? hstepAp : (mode) == 2 ? (size_t)64 * K * 2 : hstep)
#define PG8_AMODE(pn) (Epi::A_PERM_PN == 0 ? 0 : ((pn) < 4 ? 1 : ((pn) < 6 ? 2 : 0)))
    const size_t kstep = (size_t)(BK * 2);
    const size_t hstep = (size_t)HALF * K * 2;
    const size_t tstep = 2 * hstep;
    const size_t hstepAp = (size_t)8 * K * 2;
    const unsigned ldsw = (unsigned)wid * 1024u;
    const int aoff = lds_byte(wr * 64 + fr, fq * 8), boff = lds_byte(wc * 32 + fr, fq * 8);
#define PG8_SA(b, h) (((b) * 2 + (h)) * HTB)
#define PG8_SB(b, h) ((4 + (b) * 2 + (h)) * HTB)
#define PG8_STAGE(bufoff, gbase, voff) do { _Pragma("unroll") for (int _i = 0; _i < 2; ++_i) \
        __builtin_amdgcn_global_load_lds((const unsigned*)((const char*)(gbase) + (voff)[_i]), (PG8_LAS unsigned*)(lds + (bufoff) + ldsw + _i * 8192), 16, 0, 0); } while (0)
#define PG8_LDA(dst, b, h) do { _Pragma("unroll") for (int m = 0; m < 4; ++m) _Pragma("unroll") for (int k = 0; k < 2; ++k) dst[m][k] = *(const PG8_LAS bf16x8*)(lds + PG8_SA(b, h) + aoff + m * 2048 + k * 1024); } while (0)
#define PG8_LDB(dst, b, h) do { _Pragma("unroll") for (int n = 0; n < 2; ++n) _Pragma("unroll") for (int k = 0; k < 2; ++k) dst[n][k] = *(const PG8_LAS bf16x8*)(lds + PG8_SB(b, h) + boff + n * 2048 + k * 1024); } while (0)
#define PG8_MMA(ai, bj, At, Bt) do { __builtin_amdgcn_s_setprio(1); _Pragma("unroll") for (int m = 0; m < 4; ++m) _Pragma("unroll") for (int n = 0; n < 2; ++n) _Pragma("unroll") for (int k = 0; k < 2; ++k) \
        acc[ai][bj][m][n] = __builtin_amdgcn_mfma_f32_16x16x32_bf16(Bt[n][k], At[m][k], acc[ai][bj][m][n], 0, 0, 0); __builtin_amdgcn_s_setprio(0); } while (0)
#define PG8_WAIT_V(n) asm volatile("s_waitcnt vmcnt(" #n ")" ::: "memory")
#define PG8_WAIT_L(n) asm volatile("s_waitcnt lgkmcnt(" #n ")" ::: "memory")
#define PG8_BAR __builtin_amdgcn_s_barrier()
#define PG8_SCHED __builtin_amdgcn_sched_barrier(0)
    Unit cur, nxt; int ui = 0;
    if (!S.next(0, cur)) return;
    f32x4 acc[2][2][4][2];
#pragma unroll
    for (int a = 0; a < 2; ++a)
#pragma unroll
        for (int b = 0; b < 2; ++b)
#pragma unroll
            for (int m = 0; m < 4; ++m)
#pragma unroll
                for (int n = 0; n < 2; ++n) acc[a][b][m][n] = (f32x4){0.f, 0.f, 0.f, 0.f};
    bf16x8 At[4][2], B0[2][2], B1[2][2];
    const char* cA = (const char*)g.A + (size_t)cur.pm * tstep; const char* cB = (const char*)g.Bt + (size_t)cur.pn * tstep;
    unsigned vAc[2] = {voffA[0], voffA[1]}; size_t hAc = hstep;
    if constexpr (Epi::A_PERM_PN > 0) { const int m0_ = PG8_AMODE(cur.pn); if (m0_ != 0) { PG8_AOFF(vAc, m0_); hAc = PG8_AHALF(m0_); } }
    S.a_ready(cur);
    if constexpr (SP2 && PRE) {
        static_assert(!PRE || Epi::A_PERM_PN == 0, "pre-issued prologues take their A rows in token order");
        if (wr == 1) PG8_BAR;
        PG8_WAIT_V(0); PG8_BAR;
        PG8_WAIT_V(0); PG8_BAR;
    } else if constexpr (SP2) {
        PG8_STAGE(PG8_SB(0, 0), cB, voffB); PG8_STAGE(PG8_SB(0, 1), cB + hstep, voffB); PG8_STAGE(PG8_SA(0, 0), cA, vAc); PG8_STAGE(PG8_SA(0, 1), cA + hAc, vAc);
        if (wr == 1) PG8_BAR;
        PG8_WAIT_V(2); PG8_BAR;
        PG8_STAGE(PG8_SB(1, 0), cB + kstep, voffB); PG8_STAGE(PG8_SA(1, 0), cA + kstep, vAc); PG8_STAGE(PG8_SB(1, 1), cB + hstep + kstep, voffB);
        PG8_WAIT_V(6); PG8_BAR;
    } else {
        PG8_STAGE(PG8_SB(0, 0), cB, voffB); PG8_STAGE(PG8_SA(0, 0), cA, vAc); PG8_STAGE(PG8_SB(0, 1), cB + hstep, voffB); PG8_STAGE(PG8_SA(0, 1), cA + hAc, vAc);
        if (wr == 1) PG8_BAR;
        PG8_WAIT_V(4); PG8_BAR;
        PG8_STAGE(PG8_SB(1, 0), cB + kstep, voffB); PG8_STAGE(PG8_SA(1, 0), cA + kstep, vAc); PG8_STAGE(PG8_SB(1, 1), cB + hstep + kstep, voffB);
        PG8_WAIT_V(6); PG8_BAR;
    }
    for (;;) {
        const bool has_next = S.next(ui + 1, nxt);
        const char* nA = has_next ? (const char*)g.A + (size_t)nxt.pm * tstep : cA; const char* nB = has_next ? (const char*)g.Bt + (size_t)nxt.pn * tstep : cB;
        for (int t = 0; t < nt; t += 2) {
            const bool last = (t == nt - 2);
#define PG8_ASWITCH do { if constexpr (Epi::A_PERM_PN > 0) { if (last && has_next) { const int _p = PG8_AMODE(nxt.pn); PG8_AOFF(vAc, _p); hAc = PG8_AHALF(_p); } } } while (0)
            const char* a1 = cA + (size_t)(t + 1) * kstep;
            const char* a2 = last ? nA : cA + (size_t)(t + 2) * kstep; const char* b2 = last ? nB : cB + (size_t)(t + 2) * kstep;
            const char* a3 = a2 + kstep; const char* b3 = b2 + kstep;
            if (last && has_next) S.a_ready(nxt);
            if constexpr (SP2) {
            PG8_LDB(B0, 0, 0); PG8_LDB(B1, 0, 1); PG8_SCHED; PG8_LDA(At, 0, 0); PG8_STAGE(PG8_SA(1, 1), a1 + hAc, vAc); PG8_ASWITCH;
            PG8_WAIT_V(8); PG8_WAIT_L(0); PG8_BAR; PG8_MMA(0, 0, At, B0); PG8_MMA(0, 1, At, B1); PG8_BAR; PG8_SCHED;
            PG8_LDA(At, 0, 1); PG8_STAGE(PG8_SB(0, 0), b2, voffB); PG8_STAGE(PG8_SB(0, 1), b2 + hstep, voffB); PG8_STAGE(PG8_SA(0, 0), a2, vAc);
            PG8_WAIT_V(8); PG8_WAIT_L(0); PG8_BAR; PG8_MMA(1, 0, At, B0); PG8_MMA(1, 1, At, B1); PG8_BAR; PG8_SCHED;
            PG8_LDB(B0, 1, 0); PG8_LDB(B1, 1, 1); PG8_SCHED; PG8_LDA(At, 1, 0); PG8_STAGE(PG8_SA(0, 1), a2 + hAc, vAc);
            PG8_WAIT_V(8); PG8_WAIT_L(0); PG8_BAR; PG8_MMA(0, 0, At, B0); PG8_MMA(0, 1, At, B1); PG8_BAR; PG8_SCHED;
            PG8_LDA(At, 1, 1); PG8_STAGE(PG8_SB(1, 0), b3, voffB); PG8_STAGE(PG8_SB(1, 1), b3 + hstep, voffB); PG8_STAGE(PG8_SA(1, 0), a3, vAc);
            PG8_WAIT_V(8); PG8_WAIT_L(0); PG8_BAR; PG8_MMA(1, 0, At, B0); PG8_MMA(1, 1, At, B1); PG8_BAR; PG8_SCHED;
            } else {
            PG8_LDB(B0, 0, 0); PG8_SCHED; PG8_LDA(At, 0, 0); PG8_STAGE(PG8_SA(1, 1), a1 + hAc, vAc); PG8_ASWITCH;
            PG8_WAIT_L(8); PG8_BAR; PG8_WAIT_L(0); PG8_MMA(0, 0, At, B0); PG8_BAR; PG8_SCHED;
            PG8_LDB(B1, 0, 1); PG8_STAGE(PG8_SB(0, 0), b2, voffB);
            PG8_BAR; PG8_WAIT_L(0); PG8_MMA(0, 1, At, B1); PG8_BAR;
            PG8_LDA(At, 0, 1); PG8_STAGE(PG8_SA(0, 0), a2, vAc);
            PG8_BAR; PG8_WAIT_L(0); PG8_MMA(1, 0, At, B0); PG8_BAR; PG8_SCHED;
            PG8_STAGE(PG8_SB(0, 1), b2 + hstep, voffB);
            PG8_WAIT_V(6); PG8_BAR; PG8_MMA(1, 1, At, B1); PG8_BAR;
            PG8_LDB(B0, 1, 0); PG8_SCHED; PG8_LDA(At, 1, 0); PG8_STAGE(PG8_SA(0, 1), a2 + hAc, vAc);
            PG8_WAIT_L(8); PG8_BAR; PG8_WAIT_L(0); PG8_MMA(0, 0, At, B0); PG8_BAR; PG8_SCHED;
            PG8_LDB(B1, 1, 1); PG8_STAGE(PG8_SB(1, 0), b3, voffB);
            PG8_BAR; PG8_WAIT_L(0); PG8_MMA(0, 1, At, B1); PG8_BAR;
            PG8_LDA(At, 1, 1); PG8_STAGE(PG8_SA(1, 0), a3, vAc);
            PG8_BAR; PG8_WAIT_L(0); PG8_MMA(1, 0, At, B0); PG8_BAR; PG8_SCHED;
            PG8_STAGE(PG8_SB(1, 1), b3 + hstep, voffB);
            PG8_WAIT_V(6); PG8_BAR; PG8_MMA(1, 1, At, B1); PG8_BAR;
            }
        }
        if constexpr (ALIGN_EPI) { if (wr == 0) PG8_BAR; }
        if constexpr (!Epi::AFTER_DRAIN) { E(acc, cur, wr, wc, fr, fq); S.done(cur); }
        if (!has_next) break;
#pragma unroll
        for (int a = 0; a < 2; ++a)
#pragma unroll
            for (int b = 0; b < 2; ++b)
#pragma unroll
                for (int m = 0; m < 4; ++m)
#pragma unroll
                    for (int n = 0; n < 2; ++n) acc[a][b][m][n] = (f32x4){0.f, 0.f, 0.f, 0.f};
        cur = nxt; cA = nA; cB = nB; ++ui;
        if constexpr (ALIGN_EPI) { if (wr == 1) PG8_BAR; }
    }
    PG8_WAIT_V(0);
    if constexpr (!ALIGN_EPI) { if (wr == 0) PG8_BAR; }
    PG8_BAR;
    if constexpr (Epi::AFTER_DRAIN) { E.fused(acc, cur, wr, wc, fr, fq, lds, wid, lane); S.done(cur); }
#undef PG8_ASWITCH
#undef PG8_AOFF
#undef PG8_AHALF
#undef PG8_AMODE
#undef PG8_SA
#undef PG8_SB
#undef PG8_STAGE
#undef PG8_LDA
#undef PG8_LDB
#undef PG8_MMA
#undef PG8_WAIT_V
#undef PG8_WAIT_L
#undef PG8_BAR
#undef PG8_SCHED
}
}

constexpr int NTHREADS = 512, NWAVES = 8;
constexpr int LDS_BYTES = 147456;
struct Args { const float* in[13]; float* out; unsigned char* ws; };
constexpr int CW_BAR = 4096;
constexpr size_t CTL_ZERO_BYTES = 65536;
constexpr int MISC_OFF = 131072 + 8192;


#define LAS __attribute__((address_space(3)))
typedef unsigned u32x4 __attribute__((ext_vector_type(4)));
typedef unsigned u32x2 __attribute__((ext_vector_type(2)));
typedef float f32x4 __attribute__((ext_vector_type(4)));
typedef __bf16 bf16x2_t __attribute__((ext_vector_type(2)));
typedef float f32x2_cv __attribute__((ext_vector_type(2)));
__device__ __forceinline__ unsigned pk2(float lo, float hi) { const f32x2_cv v = {lo, hi}; return __builtin_bit_cast(unsigned, __builtin_convertvector(v, bf16x2_t)); }

struct EpiProj {
    static constexpr int A_PERM_PN = 4;
    static constexpr bool PERM = true, AFTER_DRAIN = false;
    const float* rs1; const float* qg; const float* kg; const float2* rope; bf16_t* Q; bf16_t* Kb; bf16_t* V; bf16_t* P;
    __device__ __forceinline__ void operator()(const f32x4 (&acc)[2][2][4][2], const pg8::Unit& u, int wr, int wc, int fr, int fq) const {
        const int pn = u.pn;
        asm volatile("" : "+v"(fr), "+v"(fq));
        if (pn < 4) {
            const int head = 4 * (pn & 1) + wc; const bool isq = pn < 2; const float* g = isq ? qg : kg; bf16_t* dst = isq ? Q : Kb; const float osc = isq ? QSCALE : 1.0f;
            f32x4 gv[2][2];
#pragma unroll
            for (int bj = 0; bj < 2; ++bj)
#pragma unroll
                for (int n = 0; n < 2; ++n) gv[bj][n] = *(const f32x4*)(g + 32 * bj + 8 * fq + 4 * n);
            float rsn; f32x4 csn[2][2];
#define EPQ_LOAD(it_) do { const int row_ = u.pm * 256 + 16 * fr + (8 * ((it_) >> 2) + 4 * wr + ((it_) & 3)); const int pos_ = row_ & (S - 1); rsn = rs1[row_]; \
            _Pragma("unroll") for (int n = 0; n < 2; ++n) { const float* rp_ = (const float*)rope + (size_t)((((pos_ >> 8) * 16 + (pos_ & 15)) * 2 + n) * 2 * 64 + (16 * fq + fr)) * 4; \
                csn[n][0] = *(const f32x4*)rp_; csn[n][1] = *(const f32x4*)(rp_ + 64 * 4); } } while (0)
            EPQ_LOAD(0);
#pragma unroll
            for (int ai = 0; ai < 2; ++ai)
#pragma unroll
                for (int m = 0; m < 4; ++m) {
                    const int row = u.pm * 256 + 16 * fr + (8 * ai + 4 * wr + m); const float rs = rsn; const int pos = row & (S - 1);
                    const f32x4 cs00 = csn[0][0], cs01 = csn[0][1], cs10 = csn[1][0], cs11 = csn[1][1];
                    if (4 * ai + m < 7) EPQ_LOAD(4 * ai + m + 1);
                    f32x4 v[2][2]; float ss = 0.f;
#pragma unroll
                    for (int bj = 0; bj < 2; ++bj)
#pragma unroll
                        for (int n = 0; n < 2; ++n) { v[bj][n] = acc[ai][bj][m][n] * rs; const f32x4 t = v[bj][n]; ss += (t[0] * t[0] + t[1] * t[1]) + (t[2] * t[2] + t[3] * t[3]); }
                    ss += __shfl_xor(ss, 16); ss += __shfl_xor(ss, 32);
                    const float rr = __builtin_amdgcn_rsqf(ss * (1.0f / 64.0f) + EPS);
                    u32x4 w1, w2;
#pragma unroll
                    for (int n = 0; n < 2; ++n) {
                        const f32x4 csA = n == 0 ? cs00 : cs10, csB = n == 0 ? cs01 : cs11;
                        const f32x4 y1 = v[0][n] * rr * gv[0][n], y2 = v[1][n] * rr * gv[1][n];
                        const f32x4 c = {csA[0], csA[2], csB[0], csB[2]}, s = {csA[1], csA[3], csB[1], csB[3]};
                        const f32x4 o1 = (y1 * c - y2 * s) * osc, o2 = (y2 * c + y1 * s) * osc;
                        if (n == 0) { w1.x = pk2(o1[0], o1[1]); w1.y = pk2(o1[2], o1[3]); w2.x = pk2(o2[0], o2[1]); w2.y = pk2(o2[2], o2[3]); }
                        else        { w1.z = pk2(o1[0], o1[1]); w1.w = pk2(o1[2], o1[3]); w2.z = pk2(o2[0], o2[1]); w2.w = pk2(o2[2], o2[3]); }
                    }
                    bf16_t* rowp = dst + (size_t)((row >> 13) * 8 + head) * 524288 + (size_t)(((pos & 15) * 32 + (pos >> 8)) * 8 + fq) * 128 + ((pos >> 4) & 15) * 8;
                    *(u32x4*)(rowp) = w1; *(u32x4*)(rowp + 4 * 128) = w2;
                }
#undef EPQ_LOAD
        } else if (pn < 6) {
            { const int tbase = u.pm * 256; const int b = tbase >> 13, tile = (tbase & 8191) >> 8;
              float rs[2][4];
#pragma unroll
              for (int ai = 0; ai < 2; ++ai)
#pragma unroll
                  for (int m = 0; m < 4; ++m) rs[ai][m] = rs1[tbase + 16 * (8 * wr + 4 * ai + m) + fr];
#pragma unroll
              for (int bj = 0; bj < 2; ++bj) { const int head = (pn - 4) * 4 + 2 * bj + (wc >> 1);
#pragma unroll
                  for (int n = 0; n < 2; ++n)
#pragma unroll
                      for (int i = 0; i < 4; ++i) { const int dim_ = (wc & 1) * 32 + 8 * fq + 4 * n + i; const int dim = 16 * ((dim_ >> 2) & 3) + 4 * (dim_ >> 4) + (dim_ & 3);
                          u32x4 w; w.x = pk2(acc[0][bj][0][n][i] * rs[0][0], acc[0][bj][1][n][i] * rs[0][1]); w.y = pk2(acc[0][bj][2][n][i] * rs[0][2], acc[0][bj][3][n][i] * rs[0][3]);
                          w.z = pk2(acc[1][bj][0][n][i] * rs[1][0], acc[1][bj][1][n][i] * rs[1][1]); w.w = pk2(acc[1][bj][2][n][i] * rs[1][2], acc[1][bj][3][n][i] * rs[1][3]);
                          *(u32x4*)(V + (size_t)(b * 8 + head) * 524288 + (size_t)((fr * 32 + tile) * 64 + dim) * 16 + 8 * wr) = w; } } }
        } else {
            bf16_t* dst = P; const int colbase = (pn & 1) * 256 + wc * 32 + 8 * fq;
            float rsv[2][4];
#pragma unroll
            for (int ai = 0; ai < 2; ++ai)
#pragma unroll
                for (int m = 0; m < 4; ++m) rsv[ai][m] = rs1[u.pm * 256 + ai * 128 + wr * 64 + m * 16 + fr];
#pragma unroll
            for (int ai = 0; ai < 2; ++ai)
#pragma unroll
                for (int m = 0; m < 4; ++m) {
                    const int row = u.pm * 256 + ai * 128 + wr * 64 + m * 16 + fr; const float rs = rsv[ai][m];
#pragma unroll
                    for (int bj = 0; bj < 2; ++bj) { const f32x4 a = acc[ai][bj][m][0] * rs, b = acc[ai][bj][m][1] * rs; u32x4 w; w.x = pk2(a[0], a[1]); w.y = pk2(a[2], a[3]); w.z = pk2(b[0], b[1]); w.w = pk2(b[2], b[3]);
                        *(u32x4*)(dst + (size_t)row * 512 + colbase + bj * 128) = w; }
                }
        }
    }
};
__device__ __forceinline__ int win_src_col(int n0p) { const int pn = n0p >> 8; if (pn >= 4) return n0p; const int bj = (n0p >> 7) & 1, wc = (n0p >> 5) & 3; return 512 * (pn >> 1) + (4 * (pn & 1) + wc) * 64 + 32 * bj; }

struct EpiOut {
    static constexpr int A_PERM_PN = 0;
    static constexpr bool PERM = true, AFTER_DRAIN = false;
    const bf16_t* xb; float* out; bf16_t* xb2; float* ss2;
    __device__ __forceinline__ void operator()(const f32x4 (&acc)[2][2][4][2], const pg8::Unit& u, int wr, int wc, int fr, int fq) const {
        const int col0 = u.pn * 256 + wc * 32 + 8 * fq;
        u32x4 xn[2];
#define EPO_LOAD(it_) do { const size_t off_ = (size_t)(u.pm * 256 + ((it_) >> 2) * 128 + wr * 64 + ((it_) & 3) * 16 + fr) * D + col0; \
        xn[0] = __builtin_nontemporal_load((const u32x4*)(xb + off_)); xn[1] = __builtin_nontemporal_load((const u32x4*)(xb + off_ + 128)); } while (0)
        EPO_LOAD(0);
#pragma unroll
        for (int ai = 0; ai < 2; ++ai)
#pragma unroll
            for (int m = 0; m < 4; ++m) {
                const int row = u.pm * 256 + ai * 128 + wr * 64 + m * 16 + fr; const size_t off = (size_t)row * D + col0; float ss = 0.f;
                const u32x4 xc[2] = {xn[0], xn[1]};
                if (4 * ai + m < 7) EPO_LOAD(4 * ai + m + 1);
#pragma unroll
                for (int bj = 0; bj < 2; ++bj) { const u32x4 xw = xc[bj];
                    const f32x4 v0 = (f32x4){__uint_as_float(xw.x << 16), __uint_as_float(xw.x & 0xffff0000u), __uint_as_float(xw.y << 16), __uint_as_float(xw.y & 0xffff0000u)} + acc[ai][bj][m][0];
                    const f32x4 v1 = (f32x4){__uint_as_float(xw.z << 16), __uint_as_float(xw.z & 0xffff0000u), __uint_as_float(xw.w << 16), __uint_as_float(xw.w & 0xffff0000u)} + acc[ai][bj][m][1];
                    ss += ((v0[0] * v0[0] + v0[1] * v0[1]) + (v0[2] * v0[2] + v0[3] * v0[3])) + ((v1[0] * v1[0] + v1[1] * v1[1]) + (v1[2] * v1[2] + v1[3] * v1[3]));
                    u32x4 w; w.x = pk2(v0[0], v0[1]); w.y = pk2(v0[2], v0[3]); w.z = pk2(v1[0], v1[1]); w.w = pk2(v1[2], v1[3]); *(u32x4*)(xb2 + off + bj * 128) = w; }
                ss += __shfl_xor(ss, 16); ss += __shfl_xor(ss, 32);
                if (fq == 0) ss2[(size_t)row * 16 + u.pn * 4 + wc] = ss;
            }
#undef EPO_LOAD
    }
};


__device__ __forceinline__ unsigned dpp_xor1(unsigned v) { return (unsigned)__builtin_amdgcn_update_dpp(0, (int)v, 0xB1, 0xf, 0xf, false); }
__device__ __forceinline__ unsigned dpp_xor2(unsigned v) { return (unsigned)__builtin_amdgcn_update_dpp(0, (int)v, 0x4E, 0xf, 0xf, false); }
__device__ __forceinline__ unsigned tag_of(unsigned t0, unsigned t1, unsigned t2, unsigned t3, int i) {
    const unsigned sel = ((unsigned)i & 7u) | 0x0C0C0C00u; const unsigned lo = __builtin_amdgcn_perm(t1, t0, sel), hi = __builtin_amdgcn_perm(t3, t2, sel); return (i & 8) ? hi : lo; }
#define CE(a, b) do { const unsigned hi_ = (a) > (b) ? (a) : (b), lo_ = (a) > (b) ? (b) : (a); (a) = hi_; (b) = lo_; } while (0)
template <int O, int N> __device__ __forceinline__ void sort16_desc(unsigned (&k)[N]) {
    CE(k[O + 0], k[O + 1]); CE(k[O + 2], k[O + 3]); CE(k[O + 0], k[O + 2]); CE(k[O + 1], k[O + 3]); CE(k[O + 1], k[O + 2]); CE(k[O + 4], k[O + 5]); CE(k[O + 6], k[O + 7]); CE(k[O + 4], k[O + 6]); CE(k[O + 5], k[O + 7]); CE(k[O + 5], k[O + 6]); CE(k[O + 0], k[O + 4]); CE(k[O + 2], k[O + 6]); CE(k[O + 2], k[O + 4]); CE(k[O + 1], k[O + 5]); CE(k[O + 3], k[O + 7]); CE(k[O + 3], k[O + 5]); CE(k[O + 1], k[O + 2]); CE(k[O + 3], k[O + 4]); CE(k[O + 5], k[O + 6]); CE(k[O + 8], k[O + 9]); CE(k[O + 10], k[O + 11]); CE(k[O + 8], k[O + 10]); CE(k[O + 9], k[O + 11]); CE(k[O + 9], k[O + 10]); CE(k[O + 12], k[O + 13]); CE(k[O + 14], k[O + 15]); CE(k[O + 12], k[O + 14]); CE(k[O + 13], k[O + 15]); CE(k[O + 13], k[O + 14]); CE(k[O + 8], k[O + 12]); CE(k[O + 10], k[O + 14]); CE(k[O + 10], k[O + 12]); CE(k[O + 9], k[O + 13]); CE(k[O + 11], k[O + 15]); CE(k[O + 11], k[O + 13]); CE(k[O + 9], k[O + 10]); CE(k[O + 11], k[O + 12]); CE(k[O + 13], k[O + 14]); CE(k[O + 0], k[O + 8]); CE(k[O + 4], k[O + 12]); CE(k[O + 4], k[O + 8]); CE(k[O + 2], k[O + 10]); CE(k[O + 6], k[O + 14]); CE(k[O + 6], k[O + 10]); CE(k[O + 2], k[O + 4]); CE(k[O + 6], k[O + 8]); CE(k[O + 10], k[O + 12]); CE(k[O + 1], k[O + 9]); CE(k[O + 5], k[O + 13]); CE(k[O + 5], k[O + 9]); CE(k[O + 3], k[O + 11]); CE(k[O + 7], k[O + 15]); CE(k[O + 7], k[O + 11]); CE(k[O + 3], k[O + 5]); CE(k[O + 7], k[O + 9]); CE(k[O + 11], k[O + 13]); CE(k[O + 1], k[O + 2]); CE(k[O + 3], k[O + 4]); CE(k[O + 5], k[O + 6]); CE(k[O + 7], k[O + 8]); CE(k[O + 9], k[O + 10]); CE(k[O + 11], k[O + 12]); CE(k[O + 13], k[O + 14]);
}
__device__ __forceinline__ void merge16(unsigned (&a)[16], const unsigned (&b)[16]) {
#pragma unroll
    for (int i = 0; i < 16; ++i) a[i] = a[i] > b[15 - i] ? a[i] : b[15 - i];
#pragma unroll
    for (int d = 8; d >= 1; d >>= 1)
#pragma unroll
        for (int i = 0; i < 16; ++i) if ((i & d) == 0) CE(a[i], a[i + d]);
}
__device__ __forceinline__ unsigned cand_key(unsigned ka, unsigned kb, int a, int b) { const float sum = __uint_as_float(ka & ~0x7Fu) + __uint_as_float(kb & ~0x7Fu);
    const unsigned id = (unsigned)(16 * a + b), g4 = id & ~3u; const unsigned tw = (255u - g4) | ((254u - g4) << 8) | ((253u - g4) << 16) | ((252u - g4) << 24);
    return __builtin_amdgcn_perm(__float_as_uint(sum), tw, 0x07060500u + (id & 3u)); }
struct EpiScores {
    static constexpr int A_PERM_PN = 0;
    static constexpr bool PERM = false, AFTER_DRAIN = true;
    const float* ss2; int* idx; float* gate;
    pg8::Gemm gm; pg8::Unit nxt; bool has_next;
    __device__ __forceinline__ void write_half(const f32x4 (&a)[2][4][2], LAS float* SC, int wr, int wc, int fr, int fq) const {
#pragma unroll
        for (int m = 0; m < 4; ++m)
#pragma unroll
            for (int bj = 0; bj < 2; ++bj)
#pragma unroll
                for (int n = 0; n < 2; ++n) { const int rl = 64 * wr + 16 * m + fr, qq = 2 * bj + (wc >> 1), k = 8 * (wc & 1) + 4 * n + fq;
                    *(LAS f32x4*)(SC + rl * 256 + 64 * qq + 4 * (k ^ ((rl + 4 * qq) & 15))) = a[bj][m][n]; }
    }
    __device__ __forceinline__ float row_rs(const f32x4 sq) const {
        float t = (sq[0] + sq[1]) + (sq[2] + sq[3]);
        t += __uint_as_float(dpp_xor1(__float_as_uint(t))); t += __uint_as_float(dpp_xor2(__float_as_uint(t)));
        return __builtin_amdgcn_rsqf(t * (1.0f / D) + EPS);
    }
    __device__ __forceinline__ void select_half(LAS float* SC, int row0, int pn, int wid, int lane, bool issue_next, const float rs) const {
        const int q = lane & 3, rl = 16 * wid + (lane >> 2), rot = (rl + 4 * q) & 15;
        const int row = row0 + rl;
        unsigned tk[16];
        { unsigned key[64];
#pragma unroll
          for (int k = 0; k < 16; ++k) { const f32x4 v = *(const LAS f32x4*)(SC + rl * 256 + 64 * q + 4 * (k ^ rot));
#pragma unroll
              for (int i = 0; i < 4; ++i) { const float sc = __builtin_amdgcn_fmed3f(v[i] * rs + 8.0f, 0.125f, 15.875f); key[4 * k + i] = (__float_as_uint(sc) & ~0x7Fu) | (unsigned)(63 - (4 * k + i)); } }
          asm volatile("s_waitcnt lgkmcnt(0)" ::: "memory"); __builtin_amdgcn_s_barrier(); asm volatile("" ::: "memory");
          if (issue_next) pg8::prologue_issue<PERM>((PG8_LAS unsigned char*)SC, gm, nxt, wid * 64 + lane);
          sort16_desc<0, 64>(key); sort16_desc<16, 64>(key); sort16_desc<32, 64>(key); sort16_desc<48, 64>(key);
          unsigned t1[16], t2[16], t3[16];
#pragma unroll
          for (int i = 0; i < 16; ++i) { tk[i] = key[i]; t1[i] = key[16 + i]; t2[i] = key[32 + i]; t3[i] = key[48 + i]; }
          merge16(tk, t1); merge16(t2, t3); merge16(tk, t2);
          const unsigned cbit = (q & 1) ? 0u : 64u;
#pragma unroll
          for (int i = 0; i < 16; ++i) tk[i] |= cbit; }
        unsigned c[16];
#pragma unroll
        for (int i = 0; i < 16; ++i) { const unsigned o = dpp_xor1(tk[15 - i]); c[i] = tk[i] > o ? tk[i] : o; }
#pragma unroll
        for (int d = 8; d >= 1; d >>= 1)
#pragma unroll
            for (int i = 0; i < 16; ++i) if ((i & d) == 0) { const unsigned hi = c[i] > c[i + d] ? c[i] : c[i + d], lo = c[i] > c[i + d] ? c[i + d] : c[i]; c[i] = hi; c[i + d] = lo; }
        unsigned ka[16], kb[16]; const bool ph = (q & 2) != 0;
#pragma unroll
        for (int i = 0; i < 16; ++i) { ka[i] = (unsigned)__builtin_amdgcn_update_dpp(0, (int)c[i], 0x44, 0xf, 0xf, false); kb[i] = (unsigned)__builtin_amdgcn_update_dpp(0, (int)c[i], 0xEE, 0xf, 0xf, false); }
        unsigned best[16], vmax;
        { unsigned l1[16], sx[16], l6[16];
#pragma unroll
          for (int b = 0; b < 16; ++b) best[b] = cand_key(ka[0], kb[b], 0, b);
#pragma unroll
          for (int a = 1; a < 16; ++a) l1[a - 1] = cand_key(ka[a], kb[0], a, 0);
          l1[15] = 0u;
#pragma unroll
          for (int b = 1; b <= 7; ++b) sx[b - 1] = cand_key(ka[1], kb[b], 1, b);
#pragma unroll
          for (int b = 1; b <= 4; ++b) sx[6 + b] = cand_key(ka[2], kb[b], 2, b);
#pragma unroll
          for (int b = 1; b <= 3; ++b) sx[10 + b] = cand_key(ka[3], kb[b], 3, b);
          sx[14] = cand_key(ka[4], kb[1], 4, 1); sx[15] = cand_key(ka[4], kb[2], 4, 2);
          l6[0] = cand_key(ka[5], kb[1], 5, 1); l6[1] = cand_key(ka[6], kb[1], 6, 1); l6[2] = cand_key(ka[7], kb[1], 7, 1);
#pragma unroll
          for (int i = 3; i < 16; ++i) l6[i] = 0u;
          merge16(best, l1); sort16_desc<0, 16>(sx); merge16(sx, l6);
          vmax = best[0] > sx[0] ? best[0] : sx[0];
#pragma unroll
          for (int i = 0; i < 16; ++i) best[i] = best[i] > sx[15 - i] ? best[i] : sx[15 - i]; }
        const float v0 = __uint_as_float(vmax & ~0xFFu);
        unsigned bq[4]; float eq[4];
        unsigned m0 = q == 0 ? ~0u : 0u, m1 = q == 1 ? ~0u : 0u, m2 = q == 2 ? ~0u : 0u, m3 = q == 3 ? ~0u : 0u; asm volatile("" : "+v"(m0), "+v"(m1), "+v"(m2), "+v"(m3));
#pragma unroll
        for (int i = 0; i < 4; ++i) { bq[i] = (best[i] & m0) | (best[4 + i] & m1) | (best[8 + i] & m2) | (best[12 + i] & m3); eq[i] = __builtin_amdgcn_exp2f((__uint_as_float(bq[i] & ~0xFFu) - v0) * 1.4426950408889634f); }
        float esum = (eq[0] + eq[1]) + (eq[2] + eq[3]);
        esum += __uint_as_float(dpp_xor1(__float_as_uint(esum))); esum += __uint_as_float(dpp_xor2(__float_as_uint(esum)));
        const float inv = __builtin_amdgcn_rcpf(esum);
#define PK4(k, w) ((__builtin_amdgcn_perm((k)[4 * (w) + 1], (k)[4 * (w)], 0x0C0C0400u) | __builtin_amdgcn_perm((k)[4 * (w) + 3], (k)[4 * (w) + 2], 0x04000C0Cu)) & 0x7F7F7F7Fu)
        const unsigned ta0 = PK4(ka, 0), ta1 = PK4(ka, 1), ta2 = PK4(ka, 2), ta3 = PK4(ka, 3), tb0 = PK4(kb, 0), tb1 = PK4(kb, 1), tb2 = PK4(kb, 2), tb3 = PK4(kb, 3);
#undef PK4
        int oi[4]; float og[4];
#pragma unroll
        for (int i = 0; i < 4; ++i) { const unsigned b_ = bq[i];
            const int id = 255 - (int)(b_ & 0xFFu), a_ = id >> 4, bb = id & 15;
            const int i1 = 127 - (int)tag_of(ta0, ta1, ta2, ta3, a_), i2 = 127 - (int)tag_of(tb0, tb1, tb2, tb3, bb);
            oi[i] = i1 * 128 + i2; og[i] = eq[i] * inv; }
        { const size_t o = (size_t)row * 128 + 16 * pn + 4 * q;
          *(u32x2*)((unsigned short*)idx + o) = (u32x2){(unsigned)oi[0] | ((unsigned)oi[1] << 16), (unsigned)oi[2] | ((unsigned)oi[3] << 16)};
          *(f32x4*)(gate + o) = (f32x4){og[0], og[1], og[2], og[3]}; }
    }
    __device__ __forceinline__ void fused(f32x4 (&acc)[2][2][4][2], const pg8::Unit& u, int wr, int wc, int fr, int fq, LAS unsigned char* lds, int wid, int lane) const {
        LAS float* SC = (LAS float*)lds;
        asm volatile("" : "+v"(lane), "+v"(fr), "+v"(fq));
        const size_t sso = (size_t)(u.pm * 256 + 16 * wid + (lane >> 2)) * 16 + 4 * (lane & 3);
        const f32x4 sqA = *(const f32x4*)(ss2 + sso), sqB = *(const f32x4*)(ss2 + sso + 128 * 16);
        write_half(acc[0], SC, wr, wc, fr, fq);
        asm volatile("s_waitcnt lgkmcnt(0)" ::: "memory"); __builtin_amdgcn_s_barrier(); asm volatile("" ::: "memory");
        select_half(SC, u.pm * 256, u.pn, wid, lane, false, row_rs(sqA));
        asm volatile("" : "+v"(lane), "+v"(fr), "+v"(fq));
        write_half(acc[1], SC, wr, wc, fr, fq);
        asm volatile("s_waitcnt lgkmcnt(0)" ::: "memory"); __builtin_amdgcn_s_barrier(); asm volatile("" ::: "memory");
        select_half(SC, u.pm * 256 + 128, u.pn, wid, lane, has_next, row_rs(sqB));
    }
};
struct SingleUnit { pg8::Unit u;
    __device__ __forceinline__ bool next(int i, pg8::Unit& o) const { if (i != 0) return false; o = u; return true; }
    __device__ __forceinline__ void a_ready(const pg8::Unit&) const {}
    __device__ __forceinline__ void done(const pg8::Unit&) const {}
};


typedef short bf16x8 __attribute__((ext_vector_type(8)));
typedef short s16x4 __attribute__((ext_vector_type(4)));
struct AttnFrag { bf16x8 k00, k01, k10, k11; s16x4 v0[4], v1[4]; };
__device__ __forceinline__ void attn_load(AttnFrag& f, const bf16_t* __restrict__ Kc, const bf16_t* __restrict__ VT, size_t plane, int c0, int kb0, int c1, int kb1, int li, int lg) {
    const bf16_t* k0 = Kc + plane + (size_t)((c0 * 32 + (kb0 >> 4)) * 8 + lg) * 128 + li * 8; const bf16_t* k1 = Kc + plane + (size_t)((c1 * 32 + (kb1 >> 4)) * 8 + lg) * 128 + li * 8;
    f.k00 = *(const bf16x8*)k0; f.k01 = *(const bf16x8*)(k0 + 4 * 128); f.k10 = *(const bf16x8*)k1; f.k11 = *(const bf16x8*)(k1 + 4 * 128);
    const bf16_t* v0 = VT + plane + (size_t)(c0 * 32 + (kb0 >> 4)) * 1024 + li * 16 + 4 * lg; const bf16_t* v1 = VT + plane + (size_t)(c1 * 32 + (kb1 >> 4)) * 1024 + li * 16 + 4 * lg;
#pragma unroll
    for (int mt = 0; mt < 4; ++mt) { f.v0[mt] = *(const s16x4*)(v0 + mt * 256); f.v1[mt] = *(const s16x4*)(v1 + mt * 256); }
}
template <int TY> __device__ __forceinline__ float attn_w(int d) {
    if (TY == 3) return 1.f;
    float w = (unsigned)d <= 128u ? 1.f : 0.f;
    if (TY <= 1) w += (unsigned)d <= 512u ? 1.f : 0.f;
    if (TY == 0) w += (unsigned)d <= 2048u ? 1.f : 0.f;
    return w;
}
template <int T0, int T1> __device__ __forceinline__ void attn_step(const AttnFrag& f, const bf16x8 qf0, const bf16x8 qf1, int db0, int db1, f32x4 (&O)[4], float& lsum) {
    f32x4 s0 = {0.f, 0.f, 0.f, 0.f}, s1 = {0.f, 0.f, 0.f, 0.f};
    s0 = __builtin_amdgcn_mfma_f32_16x16x32_bf16(f.k00, qf0, s0, 0, 0, 0); s0 = __builtin_amdgcn_mfma_f32_16x16x32_bf16(f.k01, qf1, s0, 0, 0, 0);
    s1 = __builtin_amdgcn_mfma_f32_16x16x32_bf16(f.k10, qf0, s1, 0, 0, 0); s1 = __builtin_amdgcn_mfma_f32_16x16x32_bf16(f.k11, qf1, s1, 0, 0, 0);
    float p0[4], p1[4];
#pragma unroll
    for (int j = 0; j < 4; ++j) { p0[j] = attn_w<T0>(db0 - 16 * j) * __builtin_amdgcn_exp2f(s0[j]); p1[j] = attn_w<T1>(db1 - 16 * j) * __builtin_amdgcn_exp2f(s1[j]); }
    lsum += ((p0[0] + p0[1]) + (p0[2] + p0[3])) + ((p1[0] + p1[1]) + (p1[2] + p1[3]));
    u32x4 pw; pw.x = pk2(p0[0], p0[1]); pw.y = pk2(p0[2], p0[3]); pw.z = pk2(p1[0], p1[1]); pw.w = pk2(p1[2], p1[3]);
    const bf16x8 pf = __builtin_bit_cast(bf16x8, pw);
#pragma unroll
    for (int mt = 0; mt < 4; ++mt) { const bf16x8 vf = {f.v0[mt][0], f.v0[mt][1], f.v0[mt][2], f.v0[mt][3], f.v1[mt][0], f.v1[mt][1], f.v1[mt][2], f.v1[mt][3]};
        O[mt] = __builtin_amdgcn_mfma_f32_16x16x32_bf16(vf, pf, O[mt], 0, 0, 0); }
}
constexpr int ATT_LDS_V = 65536;
__device__ __forceinline__ void attn_stage(LAS unsigned char* lds, const bf16_t* __restrict__ Kc, const bf16_t* __restrict__ VT, size_t plane, int sp, int wave, int lane) {
    const int tprev = sp > 0 ? sp - 1 : 0;
#pragma unroll
    for (int i = 0; i < 16; ++i) { const int q = wave * 16 + i, isv = q >> 6, slot = (q >> 1) & 31, half = q & 1; const int c = slot >> 1, ti = (slot & 1) ? sp : tprev;
        const bf16_t* src = (isv ? VT : Kc) + plane + (size_t)(c * 32 + ti) * 1024 + half * 512 + lane * 8;
        __builtin_amdgcn_global_load_lds((const unsigned*)src, (LAS unsigned*)(lds + isv * ATT_LDS_V + slot * 2048 + half * 1024), 16, 0, 0); }
}
__device__ __forceinline__ void attn_load_lds(AttnFrag& f, const LAS unsigned char* lds, int c, int li, int lg) {
    const LAS unsigned char* k0 = lds + (2 * c) * 2048 + lg * 256 + li * 16; const LAS unsigned char* v0 = lds + ATT_LDS_V + (2 * c) * 2048 + li * 32 + lg * 8;
    f.k00 = *(const LAS bf16x8*)k0; f.k01 = *(const LAS bf16x8*)(k0 + 1024); f.k10 = *(const LAS bf16x8*)(k0 + 2048); f.k11 = *(const LAS bf16x8*)(k0 + 2048 + 1024);
#pragma unroll
    for (int mt = 0; mt < 4; ++mt) { f.v0[mt] = *(const LAS s16x4*)(v0 + mt * 512); f.v1[mt] = *(const LAS s16x4*)(v0 + 2048 + mt * 512); }
}
constexpr float U8_SCALE = 95.46f, X8_SCALE = 12.f, V4_SCALE = 5.656854f;
struct TabRow { f32x4 u[4], v[4]; };
__device__ __forceinline__ void tab_load1(TabRow& t, int row, int lane, const float* __restrict__ pu, const float* __restrict__ pv) {
#pragma unroll
    for (int q4 = 0; q4 < 4; ++q4) { const size_t o = (size_t)row * 1024 + 512 * (q4 >> 1) + 8 * lane + 4 * (q4 & 1); t.u[q4] = __builtin_nontemporal_load((const f32x4*)(pu + o)); t.v[q4] = __builtin_nontemporal_load((const f32x4*)(pv + o)); }
}
__device__ __forceinline__ float clamp6(float x) { return fminf(fmaxf(x, -6.0f), 6.0f); }
__device__ __forceinline__ void tab_store1(const TabRow& t, int row, int lane, const float* __restrict__ g2, unsigned char* __restrict__ U8, unsigned char* __restrict__ V8) {
#pragma unroll
    for (int q2 = 0; q2 < 2; ++q2) { unsigned wu = 0; unsigned wv = 0;
#pragma unroll
        for (int hh = 0; hh < 2; ++hh) { const int q4 = 2 * q2 + hh; const f32x4 a = t.u[q4], c = t.v[q4];
#pragma unroll
            for (int k = 0; k < 4; ++k) { int qi = (int)floorf(a[k] * U8_SCALE); qi = qi < -8 ? -8 : qi > 7 ? 7 : qi; wu |= (unsigned)(qi & 15) << (16 * hh + 4 * k); }
            if (hh == 0) { wv = __builtin_amdgcn_cvt_scalef32_pk_fp4_f32(wv, clamp6(c[0] * V4_SCALE), clamp6(c[1] * V4_SCALE), 1.0f, 0); wv = __builtin_amdgcn_cvt_scalef32_pk_fp4_f32(wv, clamp6(c[2] * V4_SCALE), clamp6(c[3] * V4_SCALE), 1.0f, 1); }
            else         { wv = __builtin_amdgcn_cvt_scalef32_pk_fp4_f32(wv, clamp6(c[0] * V4_SCALE), clamp6(c[1] * V4_SCALE), 1.0f, 2); wv = __builtin_amdgcn_cvt_scalef32_pk_fp4_f32(wv, clamp6(c[2] * V4_SCALE), clamp6(c[3] * V4_SCALE), 1.0f, 3); } }
        *(unsigned*)(U8 + (size_t)row * 512 + 256 * q2 + 4 * lane) = wu;
        *(unsigned*)(V8 + (size_t)row * 512 + 256 * q2 + 4 * lane) = wv; }
}
__device__ __forceinline__ void attn_task(int b, int h, int sp, int r, int lane, const LAS unsigned char* lds, const bf16_t* __restrict__ Qc, const bf16_t* __restrict__ Kc, const bf16_t* __restrict__ VT, bf16_t* __restrict__ mix,
                                          int trow, const float* __restrict__ pu, const float* __restrict__ pv, const float* __restrict__ g2, unsigned char* __restrict__ U8, unsigned char* __restrict__ V8) {
    const int li = lane & 15, lg = lane >> 4, qb = 16 * sp;
    const size_t plane = (size_t)(b * 8 + h) * 8192 * 64;
    const bf16_t* qp = Qc + plane + (size_t)((r * 32 + sp) * 8 + lg) * 128 + li * 8;
    const bf16x8 qf0 = __builtin_nontemporal_load((const bf16x8*)qp), qf1 = __builtin_nontemporal_load((const bf16x8*)(qp + 4 * 128));
    f32x4 O[4];
#pragma unroll
    for (int mt = 0; mt < 4; ++mt) O[mt] = (f32x4){0.f, 0.f, 0.f, 0.f};
    float lsum = 0.f;
    const int qd = 16 * (qb + li - 4 * lg);
    const int INV = -(1 << 24);
    {
        AttnFrag fa, fb;
        const int c1 = (r - 4) & 15, c2 = (r - 8) & 15, c3 = (r - 12) & 15, kb2 = qb - 32;
        const bool v2 = kb2 >= 0; const int kb2c = v2 ? kb2 : 0;
#define KBC(k) ((k) < 0 ? 0 : (k))
#define OV(k, o) ((k) < 0 ? INV : (o))
        attn_load(fa, Kc, VT, plane, r, KBC(qb - 128), r, KBC(qb - 112), li, lg);
        attn_load(fb, Kc, VT, plane, r, KBC(qb - 96), r, KBC(qb - 80), li, lg);
        if (qb >= 128) attn_step<0, 3>(fa, qf0, qf1, qd - 16 * (qb - 128), 0, O, lsum); else attn_step<0, 0>(fa, qf0, qf1, qd - 16 * KBC(qb - 128) + OV(qb - 128, 0), qd - 16 * KBC(qb - 112) + OV(qb - 112, 0), O, lsum);
        attn_load(fa, Kc, VT, plane, r, KBC(qb - 64), r, KBC(qb - 48), li, lg);
        if (qb >= 128) attn_step<3, 3>(fb, qf0, qf1, 0, 0, O, lsum); else attn_step<0, 0>(fb, qf0, qf1, qd - 16 * KBC(qb - 96) + OV(qb - 96, 0), qd - 16 * KBC(qb - 80) + OV(qb - 80, 0), O, lsum);
        attn_load(fb, Kc, VT, plane, r, kb2c, c1, kb2c, li, lg);
        if (qb >= 128) attn_step<3, 3>(fa, qf0, qf1, 0, 0, O, lsum); else attn_step<0, 0>(fa, qf0, qf1, qd - 16 * KBC(qb - 64) + OV(qb - 64, 0), qd - 16 * KBC(qb - 48) + OV(qb - 48, 0), O, lsum);
        attn_load(fa, Kc, VT, plane, c2, kb2c, c3, kb2c, li, lg);
        attn_step<0, 1>(fb, qf0, qf1, qd - 16 * kb2c + OV(kb2, 0), qd - 16 * kb2c + OV(kb2, r - c1), O, lsum);
        attn_step<1, 1>(fa, qf0, qf1, qd - 16 * kb2c + OV(kb2, r - c2), qd - 16 * kb2c + OV(kb2, r - c3), O, lsum);
#undef KBC
#undef OV
    }
    TabRow trw; if (trow >= 0) tab_load1(trw, trow, lane, pu, pv);
    const int kbp = sp > 0 ? qb - 16 : 0; const bool vp = sp > 0;
    const int dP = qd - 16 * kbp + (vp ? 0 : INV), dC = qd - 16 * qb;
#define CLS_B(e) ((r - 4 * (e)) & 15)
#define CLS_C(x) ((r + (x) + 1 + (x) / 3) & 15)
    {
        AttnFrag fa, fb;
        attn_load_lds(fa, lds, r, li, lg);
        attn_load_lds(fb, lds, CLS_B(1), li, lg); attn_step<0, 0>(fa, qf0, qf1, dP, dC, O, lsum);
        attn_load_lds(fa, lds, CLS_B(2), li, lg); { const int o = r - CLS_B(1); attn_step<1, 1>(fb, qf0, qf1, dP + o, dC + o, O, lsum); }
        attn_load_lds(fb, lds, CLS_B(3), li, lg); { const int o = r - CLS_B(2); attn_step<1, 1>(fa, qf0, qf1, dP + o, dC + o, O, lsum); }
        attn_load_lds(fa, lds, CLS_C(0), li, lg); { const int o = r - CLS_B(3); attn_step<1, 1>(fb, qf0, qf1, dP + o, dC + o, O, lsum); }
#pragma unroll 1
        for (int x = 0; x < 12; x += 2) {
            attn_load_lds(fb, lds, CLS_C(x + 1), li, lg); { const int o = r - CLS_C(x); attn_step<2, 2>(fa, qf0, qf1, dP + o, dC + o, O, lsum); }
            const int xn = x + 2 < 12 ? x + 2 : 11;
            attn_load_lds(fa, lds, CLS_C(xn), li, lg); { const int o = r - CLS_C(x + 1); attn_step<2, 2>(fb, qf0, qf1, dP + o, dC + o, O, lsum); }
        }
    }
#undef CLS_B
#undef CLS_C
    if (trow >= 0) tab_store1(trw, trow, lane, g2, U8, V8);
    lsum += __shfl_xor(lsum, 16); lsum += __shfl_xor(lsum, 32);
    const float inv = 1.0f / lsum;
    bf16_t* op = mix + (size_t)(b * 8192 + 16 * (qb + li) + r) * 1024 + h * 64 + 16 * lg;
    { u32x4 w; w.x = pk2(O[0][0] * inv, O[0][1] * inv); w.y = pk2(O[0][2] * inv, O[0][3] * inv); w.z = pk2(O[1][0] * inv, O[1][1] * inv); w.w = pk2(O[1][2] * inv, O[1][3] * inv); *(u32x4*)op = w; }
    { u32x4 w; w.x = pk2(O[2][0] * inv, O[2][1] * inv); w.y = pk2(O[2][2] * inv, O[2][3] * inv); w.z = pk2(O[3][0] * inv, O[3][1] * inv); w.w = pk2(O[3][2] * inv, O[3][3] * inv); *(u32x4*)(op + 8) = w; }
}

template <int W> __device__ __forceinline__ void pooled_load(u32x4 (&wv)[W], int tq, int g, int lane, const bf16_t* __restrict__ P) {
    const int t = 4 * tq + (lane >> 4), pos = t & (S - 1), ch = g * 128 + 8 * (lane & 15); const int cnt = (pos + 1) < W ? (pos + 1) : W;
    const bf16_t* pp = P + (size_t)t * 512 + ch;
#pragma unroll
    for (int sft = 0; sft < W; ++sft) wv[sft] = *(const u32x4*)(pp - (size_t)(sft < cnt ? sft : 0) * 512);
}
template <int W> __device__ __forceinline__ void pooled_finish(const u32x4 (&wv)[W], int tq, int g, int lane, bf16_t* __restrict__ mix) {
    const int t = 4 * tq + (lane >> 4), pos = t & (S - 1), ch = g * 128 + 8 * (lane & 15); const int cnt = (pos + 1) < W ? (pos + 1) : W; const float rc = 1.0f / (float)cnt;
    float sum[8], self[8];
#pragma unroll
    for (int j = 0; j < 8; ++j) sum[j] = 0.f;
#pragma unroll
    for (int sft = 0; sft < W; ++sft) { const unsigned vv[4] = {wv[sft].x, wv[sft].y, wv[sft].z, wv[sft].w}; const float wgt = sft < cnt ? 1.f : 0.f;
#pragma unroll
        for (int j = 0; j < 4; ++j) { const float lo = __uint_as_float(vv[j] << 16), hi = __uint_as_float(vv[j] & 0xffff0000u);
            if (sft == 0) { self[2 * j] = lo; self[2 * j + 1] = hi; }
            sum[2 * j] += wgt * lo; sum[2 * j + 1] += wgt * hi; } }
    u32x4 pw; pw.x = pk2(sum[0] * rc - self[0], sum[1] * rc - self[1]); pw.y = pk2(sum[2] * rc - self[2], sum[3] * rc - self[3]);
    pw.z = pk2(sum[4] * rc - self[4], sum[5] * rc - self[5]); pw.w = pk2(sum[6] * rc - self[6], sum[7] * rc - self[7]);
    *(u32x4*)(mix + (size_t)t * 1024 + 512 + ch) = pw;
}
template <int W> __device__ __forceinline__ void pooled_task(int tq, int g, int lane, const bf16_t* __restrict__ P, bf16_t* __restrict__ mix) { u32x4 wv[W]; pooled_load<W>(wv, tq, g, lane, P); pooled_finish<W>(wv, tq, g, lane, mix); }
template <int W, int R> __device__ __forceinline__ void pooled_run_load(u32x4 (&rw)[W + R - 1], int tqr, int g, int lane, const bf16_t* __restrict__ P) {
    const int tb = 4 * R * tqr + R * (lane >> 4), pos0 = tb & (S - 1), ch = g * 128 + 8 * (lane & 15);
    const bf16_t* pp = P + (size_t)tb * 512 + ch;
#pragma unroll
    for (int i = 0; i < W + R - 1; ++i) { const int rel = i - (W - 1); rw[i] = *(const u32x4*)(pp + (ptrdiff_t)((pos0 + rel >= 0) ? rel : 0) * 512); }
}
template <int W, int R> __device__ __forceinline__ void pooled_run_finish(const u32x4 (&rw)[W + R - 1], int tqr, int g, int lane, bf16_t* __restrict__ mix) {
    const int tb = 4 * R * tqr + R * (lane >> 4), pos0 = tb & (S - 1), ch = g * 128 + 8 * (lane & 15);
    float core[8];
#pragma unroll
    for (int j = 0; j < 8; ++j) core[j] = 0.f;
#pragma unroll
    for (int i = R - 1; i <= W - 1; ++i) { const float wgt = (pos0 + i - (W - 1) >= 0) ? 1.f : 0.f; const unsigned vv[4] = {rw[i].x, rw[i].y, rw[i].z, rw[i].w};
#pragma unroll
        for (int j = 0; j < 4; ++j) { core[2 * j] += wgt * __uint_as_float(vv[j] << 16); core[2 * j + 1] += wgt * __uint_as_float(vv[j] & 0xffff0000u); } }
#pragma unroll
    for (int k = 0; k < R; ++k) {
        float sum[8];
#pragma unroll
        for (int j = 0; j < 8; ++j) sum[j] = core[j];
#pragma unroll
        for (int i = k; i <= k + W - 1; ++i) { if (i >= R - 1 && i <= W - 1) continue;
            const float wgt = (pos0 + i - (W - 1) >= 0) ? 1.f : 0.f; const unsigned vv[4] = {rw[i].x, rw[i].y, rw[i].z, rw[i].w};
#pragma unroll
            for (int j = 0; j < 4; ++j) { sum[2 * j] += wgt * __uint_as_float(vv[j] << 16); sum[2 * j + 1] += wgt * __uint_as_float(vv[j] & 0xffff0000u); } }
        const int cnt = (pos0 + k + 1) < W ? (pos0 + k + 1) : W; const float rc = 1.0f / (float)cnt;
        const unsigned sv[4] = {rw[W - 1 + k].x, rw[W - 1 + k].y, rw[W - 1 + k].z, rw[W - 1 + k].w};
        u32x4 pw;
        pw.x = pk2(sum[0] * rc - __uint_as_float(sv[0] << 16), sum[1] * rc - __uint_as_float(sv[0] & 0xffff0000u)); pw.y = pk2(sum[2] * rc - __uint_as_float(sv[1] << 16), sum[3] * rc - __uint_as_float(sv[1] & 0xffff0000u));
        pw.z = pk2(sum[4] * rc - __uint_as_float(sv[2] << 16), sum[5] * rc - __uint_as_float(sv[2] & 0xffff0000u)); pw.w = pk2(sum[6] * rc - __uint_as_float(sv[3] << 16), sum[7] * rc - __uint_as_float(sv[3] & 0xffff0000u));
        *(u32x4*)(mix + (size_t)(tb + k) * 1024 + 512 + ch) = pw; }
}
__device__ __forceinline__ void mm128x64_f32(const LAS float* S_l, const LAS float* A_l, int wave, int lane, f32x4 (&acc)[4]);
__device__ __forceinline__ void p0_poolfold_item(int item, int tid, LAS float* lf, const float* __restrict__ w_out, const float* __restrict__ pool_w, const float* __restrict__ pool_scale, bf16_t* __restrict__ WoutT) {
    const int g = item >> 4, n0 = (item & 15) * 64, wave = tid >> 6, lane = tid & 63;
    LAS float* A_l = lf; LAS float* S_l = lf + 64 * 132;
#pragma unroll 8
    for (int i = 0; i < 16; ++i) { const int e = tid + 512 * i, d = e >> 6, kl = e & 63; A_l[kl * 132 + d] = w_out[(size_t)(512 + 128 * g + d) * 1024 + n0 + kl]; }
#pragma unroll 8
    for (int i = 0; i < 32; ++i) { const int e = tid + 512 * i; S_l[(e >> 7) * 132 + (e & 127)] = pool_w[(size_t)g * 16384 + e] * pool_scale[g * 128 + (e & 127)]; }
    __syncthreads();
    f32x4 acc[4]; mm128x64_f32(S_l, A_l, wave, lane, acc);
    const int j = lane & 15, q = lane >> 4;
#pragma unroll
    for (int nt = 0; nt < 4; ++nt) { u32x2 o; o.x = pk2(acc[nt][0], acc[nt][1]); o.y = pk2(acc[nt][2], acc[nt][3]);
        *(u32x2*)(WoutT + (size_t)(n0 + 16 * nt + j) * 1024 + 512 + 128 * g + 16 * wave + 4 * q) = o; }
    __syncthreads();
}

template <bool GAIN> __device__ __forceinline__ void p0_transpose_item(const float* __restrict__ W, int ldw, int src_col0, const float* __restrict__ gk, bf16_t* __restrict__ WT, int Kdim, int k0, int dst_row0, LAS float* scr, int lane) {
#pragma unroll 8
    for (int i = 0; i < 32; ++i) { const int kk = 2 * i + (lane >> 5); float v = W[(size_t)(k0 + kk) * ldw + src_col0 + (lane & 31)]; if constexpr (GAIN) v *= gk[k0 + kk]; scr[kk * 33 + (lane & 31)] = v; }
    asm volatile("s_waitcnt lgkmcnt(0)" ::: "memory");
    const int c = lane & 7;
#pragma unroll
    for (int j = 0; j < 4; ++j) { const int n = (lane >> 3) + 8 * j; const LAS float* s = scr + (8 * c) * 33 + n;
        u32x4 o; o.x = pk2(s[0 * 33], s[1 * 33]); o.y = pk2(s[2 * 33], s[3 * 33]); o.z = pk2(s[4 * 33], s[5 * 33]); o.w = pk2(s[6 * 33], s[7 * 33]);
        *(u32x4*)(WT + (size_t)(dst_row0 + n) * Kdim + k0 + 8 * c) = o; }
    asm volatile("s_waitcnt lgkmcnt(0)" ::: "memory");
}
__device__ __forceinline__ void mm128x64_f32(const LAS float* S_l, const LAS float* A_l, int wave, int lane, f32x4 (&acc)[4]) {
    const int i = lane & 15, kq = lane >> 4;
#pragma unroll
    for (int nt = 0; nt < 4; ++nt) acc[nt] = (f32x4){0.f, 0.f, 0.f, 0.f};
    const LAS float* sp = S_l + (16 * wave + i) * 132 + kq; const LAS float* ap = A_l + i * 132 + kq;
#pragma unroll 4
    for (int ks = 0; ks < 32; ++ks) { const float sv = sp[4 * ks];
#pragma unroll
        for (int nt = 0; nt < 4; ++nt) acc[nt] = __builtin_amdgcn_mfma_f32_16x16x4f32(sv, ap[nt * 16 * 132 + 4 * ks], acc[nt], 0, 0, 0); }
}
__device__ __forceinline__ void p0_wprime_item(int item, int tid, LAS float* lf, const float* __restrict__ wq, const float* __restrict__ sk, const float* __restrict__ g2, bf16_t* __restrict__ WscT) {
    const int hp = item >> 4, k0 = (item & 15) * 64, wave = tid >> 6, lane = tid & 63;
    LAS float* A_l = lf; LAS float* S_l = lf + 64 * 132;
#pragma unroll 8
    for (int i = 0; i < 16; ++i) { const int e = tid + 512 * i, r = e >> 7, c = e & 127; A_l[r * 132 + c] = wq[(size_t)(k0 + r) * 2048 + hp * 128 + c] * g2[k0 + r]; }
#pragma unroll 8
    for (int i = 0; i < 32; ++i) { const int e = tid + 512 * i; S_l[(e >> 7) * 132 + (e & 127)] = sk[(size_t)hp * 16384 + e]; }
    __syncthreads();
    f32x4 acc[4]; mm128x64_f32(S_l, A_l, wave, lane, acc);
    const int j = lane & 15, q = lane >> 4;
#pragma unroll
    for (int nt = 0; nt < 4; ++nt)
#pragma unroll
        for (int r = 0; r < 4; ++r) WscT[(size_t)(hp * 128 + 16 * wave + 4 * q + r) * 1024 + k0 + 16 * nt + j] = (bf16_t)f2bf(acc[nt][r]);
    __syncthreads();
}

__device__ __forceinline__ float dot2u(unsigned a, unsigned b, float acc) { return __builtin_amdgcn_fdot2_f32_bf16(__builtin_bit_cast(bf16x2_t, a), __builtin_bit_cast(bf16x2_t, b), acc, false); }
__device__ __forceinline__ unsigned fp8x2_bf16(unsigned w, bool hi) { return hi ? __builtin_bit_cast(unsigned, __builtin_amdgcn_cvt_scalef32_pk_bf16_fp8(w, 1.0f, true)) : __builtin_bit_cast(unsigned, __builtin_amdgcn_cvt_scalef32_pk_bf16_fp8(w, 1.0f, false)); }
__device__ __forceinline__ float dot16_fp8(const u32x4 u, const unsigned (&xq)[8]) {
    const unsigned w0 = u.x, w1 = u.y, w2 = u.z, w3 = u.w; float a = 0.f, b = 0.f;
    a = dot2u(fp8x2_bf16(w0, false), xq[0], a); b = dot2u(fp8x2_bf16(w0, true), xq[1], b);
    a = dot2u(fp8x2_bf16(w1, false), xq[2], a); b = dot2u(fp8x2_bf16(w1, true), xq[3], b);
    a = dot2u(fp8x2_bf16(w2, false), xq[4], a); b = dot2u(fp8x2_bf16(w2, true), xq[5], b);
    a = dot2u(fp8x2_bf16(w3, false), xq[6], a); b = dot2u(fp8x2_bf16(w3, true), xq[7], b);
    return a + b;
}
__device__ __forceinline__ unsigned fp4x2_bf16(unsigned w, int b) { return b == 0 ? __builtin_bit_cast(unsigned, __builtin_amdgcn_cvt_scalef32_pk_bf16_fp4(w, 1.0f, 0)) : b == 1 ? __builtin_bit_cast(unsigned, __builtin_amdgcn_cvt_scalef32_pk_bf16_fp4(w, 1.0f, 1))
                                                                            : b == 2 ? __builtin_bit_cast(unsigned, __builtin_amdgcn_cvt_scalef32_pk_bf16_fp4(w, 1.0f, 2)) : __builtin_bit_cast(unsigned, __builtin_amdgcn_cvt_scalef32_pk_bf16_fp4(w, 1.0f, 3)); }
__device__ __forceinline__ float dot32_fp4(const u32x4 u, const unsigned (&xq)[16]) {
    const unsigned w[4] = {u.x, u.y, u.z, u.w}; float a = 0.f, b = 0.f;
#pragma unroll
    for (int i = 0; i < 4; ++i) { unsigned wi = w[i]; asm volatile("" : "+v"(wi), "+v"(a));
        a = dot2u(fp4x2_bf16(wi, 0), xq[4 * i], a); b = dot2u(fp4x2_bf16(wi, 1), xq[4 * i + 1], b); a = dot2u(fp4x2_bf16(wi, 2), xq[4 * i + 2], a); b = dot2u(fp4x2_bf16(wi, 3), xq[4 * i + 3], b); }
    return a + b;
}
typedef float f32x2 __attribute__((ext_vector_type(2)));
__device__ __forceinline__ void fma16_fp8(float (&y)[16], const u32x4 v, float s) {
    const unsigned w[4] = {v.x, v.y, v.z, v.w};
#pragma unroll
    for (int i = 0; i < 4; ++i) { const f32x2 lo = __builtin_amdgcn_cvt_scalef32_pk_f32_fp8(w[i], 1.0f, false), hi = __builtin_amdgcn_cvt_scalef32_pk_f32_fp8(w[i], 1.0f, true);
        y[4 * i] += s * lo[0]; y[4 * i + 1] += s * lo[1]; y[4 * i + 2] += s * hi[0]; y[4 * i + 3] += s * hi[1]; }
}
__device__ __forceinline__ void fma32_fp4(float (&y)[32], const u32x4 v, float s) {
    const unsigned w[4] = {v.x, v.y, v.z, v.w};
#pragma unroll
    for (int i = 0; i < 4; ++i) { unsigned wi = w[i]; asm volatile("" : "+v"(wi), "+v"(y[8 * i]));
        const f32x2 p0 = __builtin_amdgcn_cvt_scalef32_pk_f32_fp4(wi, 1.0f, 0), p1 = __builtin_amdgcn_cvt_scalef32_pk_f32_fp4(wi, 1.0f, 1), p2 = __builtin_amdgcn_cvt_scalef32_pk_f32_fp4(wi, 1.0f, 2), p3 = __builtin_amdgcn_cvt_scalef32_pk_f32_fp4(wi, 1.0f, 3);
        y[8 * i] += s * p0[0]; y[8 * i + 1] += s * p0[1]; y[8 * i + 2] += s * p1[0]; y[8 * i + 3] += s * p1[1]; y[8 * i + 4] += s * p2[0]; y[8 * i + 5] += s * p2[1]; y[8 * i + 6] += s * p3[0]; y[8 * i + 7] += s * p3[1]; }
}
typedef _Float16 h16x2 __attribute__((ext_vector_type(2)));
__device__ __forceinline__ void fma32_fp4h(h16x2 (&y)[16], const u32x4 v, const h16x2 a2) {
    const unsigned w[4] = {v.x, v.y, v.z, v.w};
#pragma unroll
    for (int i = 0; i < 4; ++i) { const unsigned wi = w[i];
        y[4 * i] = __builtin_amdgcn_cvt_scalef32_pk_f16_fp4(wi, 1.0f, 0) * a2 + y[4 * i]; y[4 * i + 1] = __builtin_amdgcn_cvt_scalef32_pk_f16_fp4(wi, 1.0f, 1) * a2 + y[4 * i + 1];
        y[4 * i + 2] = __builtin_amdgcn_cvt_scalef32_pk_f16_fp4(wi, 1.0f, 2) * a2 + y[4 * i + 2]; y[4 * i + 3] = __builtin_amdgcn_cvt_scalef32_pk_f16_fp4(wi, 1.0f, 3) * a2 + y[4 * i + 3]; }
}
__device__ __forceinline__ h16x2 bc_h2(float a) { return __builtin_bit_cast(h16x2, __builtin_amdgcn_cvt_pkrtz(a, a)); }
__device__ __forceinline__ h16x2 shfl_h2(h16x2 v, int m) { return __builtin_bit_cast(h16x2, __shfl_xor(__builtin_bit_cast(unsigned, v), m)); }
__device__ __forceinline__ void p5_ids(unsigned (&e)[8], size_t t, int lane, const int* __restrict__ idx) {
    const int eg = lane >> 3; const unsigned ob = ((unsigned)t * 128u + (unsigned)(eg * 16)) << 1;
    const u32x4 a = *(const u32x4*)((const char*)idx + ob), b = *(const u32x4*)((const char*)idx + ob + 16u);
    e[0] = a.x; e[1] = a.y; e[2] = a.z; e[3] = a.w; e[4] = b.x; e[5] = b.y; e[6] = b.z; e[7] = b.w;
}
__device__ __forceinline__ void p5_pay(unsigned (&xq)[16], size_t t, int sl, int lane, const bf16_t* __restrict__ xb2) {
    const int m = lane & 7; const unsigned ob = ((unsigned)t * 1024u + (unsigned)(256 * sl + 32 * m)) << 1;
#pragma unroll
    for (int i = 0; i < 4; ++i) { const u32x4 xa = *(const u32x4*)((const char*)xb2 + ob + 16u * i); xq[4 * i] = xa.x; xq[4 * i + 1] = xa.y; xq[4 * i + 2] = xa.z; xq[4 * i + 3] = xa.w; }
}
__device__ __forceinline__ void p5_payb(unsigned (&ac)[8], size_t t, int lane, const float* __restrict__ act) {
    const int eg = lane >> 3; const unsigned ob = ((unsigned)t * 64u + (unsigned)(eg * 8)) << 2; const u32x4 a = *(const u32x4*)((const char*)act + ob), b = *(const u32x4*)((const char*)act + ob + 16u);
    ac[0] = a.x; ac[1] = a.y; ac[2] = a.z; ac[3] = a.w; ac[4] = b.x; ac[5] = b.y; ac[6] = b.z; ac[7] = b.w;
}
template <int H, int RSH = 10> __device__ __forceinline__ void p5_gather8(u32x4 (&u)[8], const unsigned (&e)[8], int sl, int lane, const unsigned char* __restrict__ TB) {
    const unsigned base = (unsigned)(128 * sl + 16 * (lane & 7));
    const __amdgpu_buffer_rsrc_t rs_ = __builtin_amdgcn_make_buffer_rsrc((void*)TB, 0, 0x7fffffff, 0x00020000);
#pragma unroll
    for (int i = 0; i < 4; ++i) { const unsigned w = e[4 * H + i];
        u[2 * i] = __builtin_amdgcn_raw_buffer_load_b128(rs_, (int)(((w & 0xffffu) << RSH) + base), 0, 16); u[2 * i + 1] = __builtin_amdgcn_raw_buffer_load_b128(rs_, (int)(((w >> 16) << RSH) + base), 0, 16); }
}
__device__ __forceinline__ void p5a_finish(float (&p)[16], size_t t, int sl, int lane, float* __restrict__ part) {
    { const bool hi = lane & 4;
#pragma unroll
      for (int i = 0; i < 8; ++i) { const float snd = hi ? p[i] : p[i + 8], kp = hi ? p[i + 8] : p[i]; p[i] = kp + __shfl_xor(snd, 4); } }
    { const bool hi = lane & 2;
#pragma unroll
      for (int i = 0; i < 4; ++i) { const float snd = hi ? p[i] : p[i + 4], kp = hi ? p[i + 4] : p[i]; p[i] = kp + __shfl_xor(snd, 2); } }
    { const bool hi = lane & 1;
#pragma unroll
      for (int i = 0; i < 2; ++i) { const float snd = hi ? p[i] : p[i + 2], kp = hi ? p[i + 2] : p[i]; p[i] = kp + __shfl_xor(snd, 1); } }
    *(unsigned*)((char*)part + ((((unsigned)t * 4u + (unsigned)sl) * 64u + (unsigned)lane) << 2)) = pk2(p[0], p[1]);
}
__device__ __forceinline__ void p5act_token(size_t t, int lane, const float* __restrict__ ss2, const float* __restrict__ part, const float* __restrict__ gate, float* __restrict__ act) {
    const float rs = 0.5f / (U8_SCALE * X8_SCALE);
    f32x2 a = {0.f, 0.f};
#pragma unroll
    for (int sl = 0; sl < 4; ++sl) { const unsigned w = ((const unsigned*)part)[(t * 4 + sl) * 64 + lane]; a[0] += __uint_as_float(w << 16); a[1] += __uint_as_float(w & 0xffff0000u); }
    const f32x2 g = *(const f32x2*)(gate + t * 128 + 2 * lane);
    const float a0 = a[0] * rs, a1 = a[1] * rs;
    float r0 = clamp6(0.5f * a0 * (1.0f + erff(a0 * 0.70710678118654752f)) * g[0]), r1 = clamp6(0.5f * a1 * (1.0f + erff(a1 * 0.70710678118654752f)) * g[1]);
    const int q = lane >> 3; unsigned char* ob = (unsigned char*)act + t * 256 + 8 * (lane & 7) + (q >> 1) + 4 * (q & 1);
#pragma unroll
    for (int r = 0; r < 4; ++r) {
        const unsigned w = (unsigned)__builtin_amdgcn_cvt_scalef32_pk_fp4_f32(0u, r0, r1, 1.0f, 0) & 0xffu;
        const f32x2 back = __builtin_amdgcn_cvt_scalef32_pk_f32_fp4(w, 1.0f, 0);
        const float m = r == 0 ? 4.0f : 8.0f; r0 = (r0 - back[0]) * m; r1 = (r1 - back[1]) * m;
        const unsigned xb = (unsigned)__shfl_xor((int)w, 8);
        const unsigned o = (q & 1) ? (((xb >> 4) & 15u) | (w & 0xf0u)) : ((w & 15u) | ((xb & 15u) << 4));
        ob[64 * r] = (unsigned char)o; }
}
__device__ __forceinline__ void p5b_finish(h16x2 (&y)[16], size_t t, int sl, int lane, float* __restrict__ out, const bf16_t* __restrict__ xb2) {
    const int m = lane & 7, eg = lane >> 3;
    { const bool hi = lane & 32;
#pragma unroll
      for (int i = 0; i < 8; ++i) { const h16x2 snd = hi ? y[i] : y[i + 8], kp = hi ? y[i + 8] : y[i]; y[i] = kp + shfl_h2(snd, 32); } }
    { const bool hi = lane & 16;
#pragma unroll
      for (int i = 0; i < 4; ++i) { const h16x2 snd = hi ? y[i] : y[i + 4], kp = hi ? y[i + 4] : y[i]; y[i] = kp + shfl_h2(snd, 16); } }
    { const bool hi = lane & 8;
#pragma unroll
      for (int i = 0; i < 2; ++i) { const h16x2 snd = hi ? y[i] : y[i + 2], kp = hi ? y[i + 2] : y[i]; y[i] = kp + shfl_h2(snd, 8); } }
    const unsigned oc = (unsigned)t * 1024u + (unsigned)(256 * sl + 32 * m + 4 * eg);
    const u32x2 xw = *(const u32x2*)((const char*)xb2 + (oc << 1));
    const f32x2 y0 = __builtin_convertvector(y[0], f32x2), y1 = __builtin_convertvector(y[1], f32x2);
    *(f32x4*)((char*)out + (oc << 2)) = (f32x4){__uint_as_float(xw.x << 16) + y0[0], __uint_as_float(xw.x & 0xffff0000u) + y0[1], __uint_as_float(xw.y << 16) + y1[0], __uint_as_float(xw.y & 0xffff0000u) + y1[1]};
}
template <int PHASE> struct P5Ch { static constexpr int CH = 64, NCH = T / CH; };
constexpr int CW_CNTA = 8192, CW_CNTB = 8192 + 1024;
struct XqIn { u32x4 r0, r1; float ss; };
__device__ __forceinline__ void xq_load(XqIn& in, size_t t, int lane, const float* __restrict__ ss2, const bf16_t* __restrict__ xb2) {
    in.ss = lane < 16 ? ss2[t * 16 + lane] : 0.f;
    const unsigned ob = ((unsigned)t * 1024u + 16u * (unsigned)lane) << 1;
    in.r0 = *(const u32x4*)((const char*)xb2 + ob); in.r1 = *(const u32x4*)((const char*)xb2 + ob + 16u);
}
__device__ __forceinline__ void xq_token(const XqIn& in, size_t t, int lane, unsigned char* __restrict__ XQ, const float (&gn)[16]) {
    const float ssum = wave_sum(in.ss);
    const float rq = X8_SCALE / sqrtf(ssum * (1.0f / D) + EPS);
    const u32x4 r0 = in.r0, r1 = in.r1;
    const unsigned w[8] = {r0.x, r0.y, r0.z, r0.w, r1.x, r1.y, r1.z, r1.w};
    unsigned hh[2] = {0u, 0u}, ll[2] = {0u, 0u};
#pragma unroll
    for (int k = 0; k < 16; ++k) { const float xv = (k & 1) ? __uint_as_float(w[k >> 1] & 0xffff0000u) : __uint_as_float(w[k >> 1] << 16);
        int x8 = (int)rintf(xv * rq * gn[k]); x8 = x8 < -120 ? -120 : x8 > 119 ? 119 : x8;
        const int xh = (x8 + 8) >> 4, xl = x8 - 16 * xh;
        hh[k >> 3] |= (unsigned)(xh & 15) << (4 * (k & 7)); ll[k >> 3] |= (unsigned)(xl & 15) << (4 * (k & 7)); }
    unsigned char* o = XQ + (size_t)t * 1024 + 32 * (lane >> 1) + 8 * (lane & 1);
    *(u32x2*)o = (u32x2){hh[0], hh[1]}; *(u32x2*)(o + 16) = (u32x2){ll[0], ll[1]};
}
__device__ __forceinline__ void p5_payq(u32x4 (&xq)[2], size_t t, int sl, int lane, const unsigned char* __restrict__ XQ) {
    const unsigned ob = (unsigned)t * 1024u + (unsigned)(32 * (8 * sl + (lane & 7)));
    xq[0] = __builtin_nontemporal_load((const u32x4*)(XQ + ob)); xq[1] = __builtin_nontemporal_load((const u32x4*)(XQ + ob + 16u));
}
__device__ __forceinline__ float dot32_i4(const u32x4 u, const u32x4 (&xq)[2], int s2) {
    int h = 0, l = 0;
    h = __builtin_amdgcn_sdot8((int)u.x, (int)xq[0].x, h, false); l = __builtin_amdgcn_sdot8((int)u.x, (int)xq[1].x, l, false);
    h = __builtin_amdgcn_sdot8((int)u.y, (int)xq[0].y, h, false); l = __builtin_amdgcn_sdot8((int)u.y, (int)xq[1].y, l, false);
    h = __builtin_amdgcn_sdot8((int)u.z, (int)xq[0].z, h, false); l = __builtin_amdgcn_sdot8((int)u.z, (int)xq[1].z, l, false);
    h = __builtin_amdgcn_sdot8((int)u.w, (int)xq[0].w, h, false); l = __builtin_amdgcn_sdot8((int)u.w, (int)xq[1].w, l, false);
    return (float)(2 * (16 * h + l) + s2);
}
__device__ __forceinline__ int sum32_i4(const u32x4 (&xq)[2]) {
    int h = 0, l = 0;
    h = __builtin_amdgcn_sdot8(0x11111111, (int)xq[0].x, h, false); h = __builtin_amdgcn_sdot8(0x11111111, (int)xq[0].y, h, false); h = __builtin_amdgcn_sdot8(0x11111111, (int)xq[0].z, h, false); h = __builtin_amdgcn_sdot8(0x11111111, (int)xq[0].w, h, false);
    l = __builtin_amdgcn_sdot8(0x11111111, (int)xq[1].x, l, false); l = __builtin_amdgcn_sdot8(0x11111111, (int)xq[1].y, l, false); l = __builtin_amdgcn_sdot8(0x11111111, (int)xq[1].z, l, false); l = __builtin_amdgcn_sdot8(0x11111111, (int)xq[1].w, l, false);
    return 16 * h + l;
}
template <int QI> __device__ __forceinline__ void p5_gather4(u32x4 (&u)[4], const unsigned (&e)[8], int sl, int lane, const unsigned char* __restrict__ TB) {
    const unsigned base = (unsigned)(128 * sl + 16 * (lane & 7));
    const __amdgpu_buffer_rsrc_t rs_ = __builtin_amdgcn_make_buffer_rsrc((void*)TB, 0, 0x7fffffff, 0x00020000);
#pragma unroll
    for (int i = 0; i < 2; ++i) { const unsigned w = e[2 * QI + i];
        u[2 * i] = __builtin_amdgcn_raw_buffer_load_b128(rs_, (int)(((w & 0xffffu) << 9) + base), 0, 16); u[2 * i + 1] = __builtin_amdgcn_raw_buffer_load_b128(rs_, (int)(((w >> 16) << 9) + base), 0, 16); }
}
__device__ __forceinline__ void p5a_ids_lds(unsigned (&e)[8], int tl, int lane, const LAS unsigned char* ib) {
    const LAS u32x4* p = (const LAS u32x4*)(ib + tl * 256 + (lane >> 3) * 32);
    const u32x4 a = p[0], b = p[1];
    e[0] = a.x; e[1] = a.y; e[2] = a.z; e[3] = a.w; e[4] = b.x; e[5] = b.y; e[6] = b.z; e[7] = b.w;
}
#define P5A_SB __builtin_amdgcn_sched_barrier(0)
#define P5A_TOK(G0, G1, G2, G3, E, XC, XL, tt_) do { \
    constexpr int CH_ = P5Ch<0>::CH; const int tl2_ = (tt_) + 2 < CH_ ? (tt_) + 2 : CH_ - 1, tl4_ = (tt_) + 4 < CH_ ? (tt_) + 4 : CH_ - 1; \
    p5_payq(XL, t0 + tl2_, sl, lane, XQ); P5A_SB; \
    const int s2_ = sum32_i4(XC); float p_[16]; \
    _Pragma("unroll") for (int i = 0; i < 4; ++i) p_[i] = dot32_i4(G0[i], XC, s2_); \
    P5A_SB; p5_gather4<0>(G0, E, sl, lane, U8); P5A_SB; \
    _Pragma("unroll") for (int i = 0; i < 4; ++i) p_[4 + i] = dot32_i4(G1[i], XC, s2_); \
    P5A_SB; p5_gather4<1>(G1, E, sl, lane, U8); P5A_SB; \
    _Pragma("unroll") for (int i = 0; i < 4; ++i) p_[8 + i] = dot32_i4(G2[i], XC, s2_); \
    P5A_SB; p5_gather4<2>(G2, E, sl, lane, U8); P5A_SB; \
    _Pragma("unroll") for (int i = 0; i < 4; ++i) p_[12 + i] = dot32_i4(G3[i], XC, s2_); \
    P5A_SB; p5_gather4<3>(G3, E, sl, lane, U8); P5A_SB; \
    p5a_ids_lds(E, tl4_, lane, ib); \
    p5a_finish(p_, t0 + (tt_), sl, lane, part); P5A_SB; } while (0)
__device__ __forceinline__ void p5_item_a(size_t t0, int sl, int lane, const unsigned char* __restrict__ XQ, const int* __restrict__ idx, const unsigned char* __restrict__ U8, float* __restrict__ part, LAS unsigned char* ib) {
    static_assert(P5Ch<0>::CH == 64, "the item's ids fill the wave's 16 KiB of LDS; four tokens per trip");
    unsigned eE[8], eO[8]; u32x4 x0[2], x1[2], x2[2], x3[2]; u32x4 a0[4], a1[4], a2[4], a3[4], b0[4], b1[4], b2[4], b3[4];
    p5_payq(x0, t0, sl, lane, XQ); p5_payq(x1, t0 + 1, sl, lane, XQ);
    {
        const unsigned char* src = (const unsigned char*)idx + t0 * 256 + (size_t)lane * 16;
#pragma unroll
        for (int k = 0; k < 16; ++k) __builtin_amdgcn_global_load_lds((const unsigned*)(src + k * 1024), (LAS unsigned*)(ib + k * 1024), 16, 0, 0);
        asm volatile("s_waitcnt vmcnt(0)" ::: "memory");
    }
    p5a_ids_lds(eE, 0, lane, ib); p5a_ids_lds(eO, 1, lane, ib);
    p5_gather4<0>(a0, eE, sl, lane, U8); p5_gather4<1>(a1, eE, sl, lane, U8); p5_gather4<2>(a2, eE, sl, lane, U8); p5_gather4<3>(a3, eE, sl, lane, U8);
    p5_gather4<0>(b0, eO, sl, lane, U8); p5_gather4<1>(b1, eO, sl, lane, U8); p5_gather4<2>(b2, eO, sl, lane, U8); p5_gather4<3>(b3, eO, sl, lane, U8);
    P5A_SB;
    p5a_ids_lds(eE, 2, lane, ib); p5a_ids_lds(eO, 3, lane, ib);
#pragma unroll 1
    for (int tt = 0; tt < P5Ch<0>::CH; tt += 4) {
        P5A_TOK(a0, a1, a2, a3, eE, x0, x2, tt);
        P5A_TOK(b0, b1, b2, b3, eO, x1, x3, tt + 1);
        P5A_TOK(a0, a1, a2, a3, eE, x2, x0, tt + 2);
        P5A_TOK(b0, b1, b2, b3, eO, x3, x1, tt + 3);
    }
    asm volatile("s_waitcnt vmcnt(0)" ::: "memory");
}
__device__ __forceinline__ void fma8rows(h16x2 (&y)[16], const u32x4 (&v)[8], const unsigned (&ac)[8], int h) {
#pragma unroll
    for (int i = 0; i < 4; ++i) { const unsigned w = h ? ac[4 + i] : ac[i]; fma32_fp4h(y, v[2 * i], bc_h2(__uint_as_float(w << 16))); fma32_fp4h(y, v[2 * i + 1], bc_h2(__uint_as_float(w & 0xffff0000u))); }
}
typedef int i32x2 __attribute__((ext_vector_type(2)));
typedef int i32x8 __attribute__((ext_vector_type(8)));
__device__ __forceinline__ void p5b_dma(LAS unsigned char* lb, const unsigned (&e)[8], int sl, int lane, const unsigned char* __restrict__ V4) {
    const int q = lane >> 3, p = lane & 7;
#pragma unroll
    for (int k = 0; k < 16; ++k) { const unsigned w = e[k >> 1]; const unsigned id = (k & 1) ? (w >> 16) : (w & 0xffffu);
        const int f = (4 * (k & 1) + (q >> 1)) & 7;
        const unsigned off = (id << 9) + (unsigned)(128 * sl + 16 * (p ^ f));
        __builtin_amdgcn_global_load_lds((const unsigned*)(V4 + off), (LAS unsigned*)(lb + k * 1024), 16, 0, 0); }
}
__device__ __forceinline__ void p5b_dma_offs(unsigned (&off)[16], const unsigned (&e)[8], int sl, int lane) {
    const int q = lane >> 3, p = lane & 7;
#pragma unroll
    for (int k = 0; k < 16; ++k) { const unsigned w = e[k >> 1]; const unsigned id = (k & 1) ? (w >> 16) : (w & 0xffffu);
        const int f = (4 * (k & 1) + (q >> 1)) & 7;
        off[k] = (id << 9) + (unsigned)(128 * sl + 16 * (p ^ f)); asm volatile("" : "+v"(off[k])); }
}
__device__ __forceinline__ void p5b_dma_issue(LAS unsigned char* lb, const unsigned (&off)[16], const unsigned char* __restrict__ V4) {
#pragma unroll
    for (int k = 0; k < 16; ++k) __builtin_amdgcn_global_load_lds((const unsigned*)(V4 + off[k]), (LAS unsigned*)(lb + k * 1024), 16, 0, 0);
}
struct ActIn { unsigned pw[4]; f32x2 g; };
__device__ __forceinline__ void p5b_act_load(ActIn& ai, size_t t, int lane, const float* __restrict__ part, const float* __restrict__ gate) {
#pragma unroll
    for (int s_ = 0; s_ < 4; ++s_) ai.pw[s_] = ((const unsigned*)part)[((unsigned)t * 4u + (unsigned)s_) * 64u + (unsigned)lane];
    ai.g = *(const f32x2*)(gate + ((unsigned)t * 128u + 2u * (unsigned)lane));
}
__device__ __forceinline__ void p5b_act_planes(const ActIn& ai, int lane, LAS unsigned char* pl) {
    const float rs = 0.5f / (U8_SCALE * X8_SCALE);
    float a0 = 0.f, a1 = 0.f;
#pragma unroll
    for (int s_ = 0; s_ < 4; ++s_) { a0 += __uint_as_float(ai.pw[s_] << 16); a1 += __uint_as_float(ai.pw[s_] & 0xffff0000u); }
    a0 *= rs; a1 *= rs;
    float r0 = clamp6(0.5f * a0 * (1.0f + erff(a0 * 0.70710678118654752f)) * ai.g[0]), r1 = clamp6(0.5f * a1 * (1.0f + erff(a1 * 0.70710678118654752f)) * ai.g[1]);
    const int q = lane >> 3; LAS unsigned char* ob = pl + 8 * (lane & 7) + (q >> 1) + 4 * (q & 1);
#pragma unroll
    for (int r = 0; r < 4; ++r) {
        const unsigned w = (unsigned)__builtin_amdgcn_cvt_scalef32_pk_fp4_f32(0u, r0, r1, 1.0f, 0) & 0xffu;
        const f32x2 back = __builtin_amdgcn_cvt_scalef32_pk_f32_fp4(w, 1.0f, 0);
        const float m = r == 0 ? 4.0f : 8.0f; r0 = (r0 - back[0]) * m; r1 = (r1 - back[1]) * m;
        const unsigned xb = (unsigned)__shfl_xor((int)w, 8);
        const unsigned o = (q & 1) ? (((xb >> 4) & 15u) | (w & 0xf0u)) : ((w & 15u) | ((xb & 15u) << 4));
        ob[64 * r] = (unsigned char)o; }
}
__device__ __forceinline__ void p5b_x2(unsigned (&x)[4], size_t t, int sl, int lane, const bf16_t* __restrict__ xb2) {
    const unsigned oc = (unsigned)t * 1024u + (unsigned)(256 * sl + 16 * (lane >> 4) + (lane & 15));
#pragma unroll
    for (int m = 0; m < 4; ++m) x[m] = *(const unsigned short*)((const char*)xb2 + ((oc + 64u * m) << 1));
}
__device__ __forceinline__ void p5b_store(const float (&y)[4], const unsigned (&x)[4], size_t t, int sl, int lane, float* __restrict__ out) {
    const unsigned oc = (unsigned)t * 1024u + (unsigned)(256 * sl + 16 * (lane >> 4) + (lane & 15));
#pragma unroll
    for (int m = 0; m < 4; ++m) __builtin_nontemporal_store(__uint_as_float(x[m] << 16) + y[m] * (1.0f / V4_SCALE), (float*)((char*)out + ((oc + 64u * m) << 2)));
}
struct P5bAct { unsigned p0, p1, p2, p3; f32x2 g; };
__device__ __forceinline__ void p5b_issue_act(P5bAct& L, size_t t, int lane, const float* __restrict__ part, const float* __restrict__ gate) {
    const unsigned ob = ((unsigned)t * 256u + (unsigned)lane) << 2, og = ((unsigned)t * 128u + 2u * (unsigned)lane) << 2;
    asm volatile("global_load_dword %0, %1, %2" : "={v208}"(L.p0) : "v"(ob), "s"(part) : "memory");
    asm volatile("global_load_dword %0, %1, %2 offset:256" : "={v209}"(L.p1) : "v"(ob), "s"(part) : "memory");
    asm volatile("global_load_dword %0, %1, %2 offset:512" : "={v210}"(L.p2) : "v"(ob), "s"(part) : "memory");
    asm volatile("global_load_dword %0, %1, %2 offset:768" : "={v211}"(L.p3) : "v"(ob), "s"(part) : "memory");
    asm volatile("global_load_dwordx2 %0, %1, %2" : "={v[212:213]}"(L.g) : "v"(og), "s"(gate) : "memory");
}
#define P5B_WAIT_ACT(n, L) asm volatile("s_waitcnt vmcnt(" #n ")" : "+{v208}"(L.p0), "+{v209}"(L.p1), "+{v210}"(L.p2), "+{v211}"(L.p3), "+{v[212:213]}"(L.g) :: "memory")
__device__ __forceinline__ void p5_item_b(size_t t0, int sl, int lane, LAS unsigned char* lb, LAS unsigned char* pl, float* __restrict__ out, const bf16_t* __restrict__ xb2, const int* __restrict__ idx, const unsigned char* __restrict__ V4,
                                          const float* __restrict__ part, const float* __restrict__ gate) {
    constexpr int CH = P5Ch<1>::CH;
    unsigned eN[8]; u32x4 aC; ActIn ai; unsigned xC[4], xN[4]; float yP[4] = {0.f, 0.f, 0.f, 0.f};
    const int sa = (lane & 3) == 0 ? 0x7f7f7f7f : (lane & 3) == 1 ? 0x7d7d7d7d : (lane & 3) == 2 ? 0x7a7a7a7a : 0x77777777;
    unsigned k0 = (lane >> 4) == 0 ? ~0u : 0u, k1 = (lane >> 4) == 1 ? ~0u : 0u, k2 = (lane >> 4) == 2 ? ~0u : 0u, k3 = (lane >> 4) == 3 ? ~0u : 0u; asm volatile("" : "+v"(k0), "+v"(k1), "+v"(k2), "+v"(k3));
    unsigned rdo[8], apo;
    { const int j_ = lane & 15, g_ = lane >> 4; const int fj_ = 16 * ((j_ >> 1) & 7);
#pragma unroll
      for (int c = 0; c < 8; ++c) { rdo[c] = (unsigned)((32 * g_ + j_) * 128 + ((16 * c) ^ fj_)); asm volatile("" : "+v"(rdo[c])); }
      apo = (unsigned)(64 * (lane & 3) + 16 * g_); asm volatile("" : "+v"(apo)); }
    p5_ids(eN, t0, lane, idx); p5b_act_load(ai, t0, lane, part, gate); p5b_x2(xN, t0, sl, lane, xb2);
    p5b_dma(lb, eN, sl, lane, V4);
    p5_ids(eN, t0 + 1, lane, idx);
    p5b_act_planes(ai, lane, pl);
#pragma unroll 1
    for (int tt = 0; tt < CH; ++tt) {
        const size_t t = t0 + tt, tn1 = t0 + (tt + 1 < CH ? tt + 1 : CH - 1), tn2 = t0 + (tt + 2 < CH ? tt + 2 : CH - 1);
        int ln = lane; asm volatile("" : "+v"(ln));
        const int j = ln & 15, g = ln >> 4;
        asm volatile("s_waitcnt vmcnt(0)" ::: "memory");
        aC = *(const LAS u32x4*)(pl + apo);
        i32x2 b[32];
        {
#pragma unroll
          for (int c = 0; c < 8; ++c) { const LAS unsigned char* pc = lb + rdo[c];
              b[4 * c] = __builtin_amdgcn_ds_read_tr4_b64_v2i32((LAS i32x2*)pc); b[4 * c + 1] = __builtin_amdgcn_ds_read_tr4_b64_v2i32((LAS i32x2*)(pc + 2048));
              b[4 * c + 2] = __builtin_amdgcn_ds_read_tr4_b64_v2i32((LAS i32x2*)(pc + 8)); b[4 * c + 3] = __builtin_amdgcn_ds_read_tr4_b64_v2i32((LAS i32x2*)(pc + 8 + 2048)); } }
        __builtin_amdgcn_sched_barrier(0);
        if (tt > 0) p5b_store(yP, xC, t - 1, sl, ln, out);
#pragma unroll
        for (int m = 0; m < 4; ++m) xC[m] = xN[m];
        P5bAct La; unsigned eT[8];
        p5b_x2(xN, tn1, sl, ln, xb2);
#pragma unroll
        for (int i = 0; i < 8; ++i) eT[i] = eN[i];
        p5_ids(eN, tn2, ln, idx);
        p5b_issue_act(La, tn1, ln, part, gate);
        unsigned go[16]; p5b_dma_offs(go, eT, sl, ln);
        __builtin_amdgcn_sched_barrier(0);
        asm volatile("s_waitcnt lgkmcnt(0)" ::: "memory");
        if (tt + 1 < CH) p5b_dma_issue(lb, go, V4);
        float y[16];
        { const i32x8 A = {(int)aC.x, (int)aC.y, (int)aC.z, (int)aC.w, 0, 0, 0, 0}; const f32x4 z = {0.f, 0.f, 0.f, 0.f};
#pragma unroll
          for (int n = 0; n < 16; ++n) { const i32x8 B = {b[2 * n][0], b[2 * n][1], b[2 * n + 1][0], b[2 * n + 1][1], 0, 0, 0, 0};
              const f32x4 c = __builtin_amdgcn_mfma_scale_f32_16x16x128_f8f6f4(A, B, z, 4, 4, 0, sa, 0, 0x7f7f7f7f);
              float v = (c[0] + c[1]) + (c[2] + c[3]); asm volatile("" : "+v"(v)); y[n] = v; } }
#pragma unroll
        for (int m = 0; m < 4; ++m) yP[m] = __uint_as_float((__float_as_uint(y[4 * m]) & k0) | (__float_as_uint(y[4 * m + 1]) & k1) | (__float_as_uint(y[4 * m + 2]) & k2) | (__float_as_uint(y[4 * m + 3]) & k3));
        P5B_WAIT_ACT(16, La);
        ai.pw[0] = La.p0; ai.pw[1] = La.p1; ai.pw[2] = La.p2; ai.pw[3] = La.p3; ai.g = La.g;
        p5b_act_planes(ai, ln, pl);
    }
    asm volatile("s_waitcnt vmcnt(0)" ::: "memory");
    p5b_store(yP, xN, t0 + CH - 1, sl, lane, out);
}
template <int PHASE> __device__ __forceinline__ void p5_sliced(unsigned* cnt, int lane, float* __restrict__ out, const bf16_t* __restrict__ xb2, const unsigned char* __restrict__ XQ, const int* __restrict__ idx, const unsigned char* __restrict__ TB, float* __restrict__ buf, LAS unsigned char* lb, LAS unsigned char* pl, const float* __restrict__ gate, int swave = -1) {
    constexpr int NSL = 4;
    if (swave >= 0) {
        const int sl = (int)(blockIdx.x & 3u); constexpr int PER = P5Ch<PHASE>::NCH / 512;
        for (int i = 0; i < PER; ++i) { const unsigned c = (unsigned)(swave * PER + i);
            if (PHASE == 0) p5_item_a((size_t)c * P5Ch<0>::CH, sl, lane, XQ, idx, TB, buf, lb); else p5_item_b((size_t)c * P5Ch<1>::CH, sl, lane, lb, pl, out, xb2, idx, TB, buf, gate); }
        return; }
    const unsigned xcc = (unsigned)__builtin_amdgcn_s_getreg((3 << 11) | 20) & 7u;
    for (int tr = 0; tr < NSL; ++tr) { const int sl = (int)((xcc + tr) & (unsigned)(NSL - 1));
        for (;;) { unsigned c = 0; if (lane == 0) c = __hip_atomic_fetch_add(cnt + 64 * sl, 1u, __ATOMIC_RELAXED, __HIP_MEMORY_SCOPE_AGENT);
            c = (unsigned)__builtin_amdgcn_readfirstlane((int)c); if (c >= (unsigned)P5Ch<PHASE>::NCH) break;
            if (PHASE == 0) p5_item_a((size_t)c * P5Ch<0>::CH, sl, lane, XQ, idx, TB, buf, lb); else p5_item_b((size_t)c * P5Ch<1>::CH, sl, lane, lb, pl, out, xb2, idx, TB, buf, gate); } }
}

#define XB_TMO      128
#define XB_XCNT(j)  (256  + 64 * (j))
#define XB_XSUB(j)  (1280 + 64 * (j))
#define XB_XGEN(j)  (2304 + 64 * (j))
#define XB_TOP      3328
#define XB_TOPGEN   3392
#define XCD_BAR_WORDS 3456
#define XB_SPIN_CAP (1u << 18)

__device__ __forceinline__ unsigned xb_ld(unsigned* p)              { return __hip_atomic_load(p, __ATOMIC_RELAXED, __HIP_MEMORY_SCOPE_AGENT); }
__device__ __forceinline__ unsigned xb_add(unsigned* p, unsigned v) { return __hip_atomic_fetch_add(p, v, __ATOMIC_RELAXED, __HIP_MEMORY_SCOPE_AGENT); }
__device__ __forceinline__ unsigned xb_xcc_id() { return (unsigned)__builtin_amdgcn_s_getreg((3 << 11) | 20) & 0xFu; }
#define XB_SPIN(cond, bar) do { unsigned _sp = 0; while (cond) { __builtin_amdgcn_s_sleep(1); \
    if ((++_sp & 255u) == 0u) { if (xb_ld(&(bar)[XB_TMO])) break; if (_sp > XB_SPIN_CAP) { atomicAdd(&(bar)[XB_TMO], 1u); break; } } } } while (0)

struct XcdBarrier {
    unsigned* bar; unsigned x;
    volatile LAS unsigned* st;
};

__device__ __forceinline__ XcdBarrier xcd_barrier_post(unsigned* bar, volatile LAS unsigned* st, int tid) {
    XcdBarrier b; b.bar = bar; b.x = xb_xcc_id(); b.st = st;
    if (tid == 0) (void)xb_add(&bar[XB_XCNT(b.x)], 1u);
    return b;
}
__device__ __forceinline__ void xcd_barrier_complete(unsigned* bar, unsigned x, unsigned& nloc, unsigned& nx) {
    const unsigned G = gridDim.x * gridDim.y * gridDim.z;
    unsigned sum, cnt, mine, sp = 0u;
    for (;;) {
        sum = 0u; cnt = 0u; mine = 0u;
#pragma unroll
        for (unsigned j = 0; j < 16; ++j) { const unsigned c = xb_ld(&bar[XB_XCNT(j)]); sum += c; cnt += (c > 0u) ? 1u : 0u; mine = (j == x) ? c : mine; }
        if (sum == G) break;
        __builtin_amdgcn_s_sleep(1);
        if ((++sp & 255u) == 0u) { if (xb_ld(&bar[XB_TMO])) break; if (sp > XB_SPIN_CAP) { atomicAdd(&bar[XB_TMO], 1u); break; } }
    }
    nloc = mine > 0u ? mine : 1u; nx = cnt > 0u ? cnt : 1u;
}

__device__ __forceinline__ void xcd_barrier(const XcdBarrier& b, int tid) {
    asm volatile("s_waitcnt vmcnt(0)" ::: "memory");
    __syncthreads();
    if (tid == 0) {
        unsigned* bar = b.bar;
        __builtin_amdgcn_s_waitcnt(0);
        unsigned nloc = b.st[0], nx = b.st[1];
        if (nloc == 0u) { xcd_barrier_complete(bar, b.x, nloc, nx); b.st[0] = nloc; b.st[1] = nx; }
        const unsigned old = xb_add(&bar[XB_XSUB(b.x)], 1u);
        const unsigned gen = old / nloc;
        if (old + 1u == (gen + 1u) * nloc) {
            __builtin_amdgcn_fence(__ATOMIC_RELEASE, "agent");
            asm volatile("s_waitcnt vmcnt(0)" ::: "memory");
            const unsigned og = xb_add(&bar[XB_TOP], 1u);
            const unsigned tg = og / nx;
            if (og + 1u == (tg + 1u) * nx) xb_add(&bar[XB_TOPGEN], 1u);
            else XB_SPIN(xb_ld(&bar[XB_TOPGEN]) == tg, bar);
            __builtin_amdgcn_fence(__ATOMIC_ACQUIRE, "agent");
            xb_add(&bar[XB_XGEN(b.x)], 1u);
            asm volatile("s_waitcnt vmcnt(0)" ::: "memory");
        } else {
            XB_SPIN(xb_ld(&bar[XB_XGEN(b.x)]) == gen, bar);
            __builtin_amdgcn_fence(__ATOMIC_ACQUIRE, "agent");
            asm volatile("s_waitcnt vmcnt(0)" ::: "memory");
        }
    }
    __syncthreads();
}

#ifndef REP_P0
#define REP_P0 1
#endif
#ifndef REP_P1
#define REP_P1 1
#endif
#ifndef REP_ATT
#define REP_ATT 1
#endif
#ifndef REP_POOL
#define REP_POOL 1
#endif
#ifndef REP_P3
#define REP_P3 1
#endif
#ifndef REP_P4
#define REP_P4 1
#endif
#ifndef REP_P5A
#define REP_P5A 1
#endif
#ifndef REP_P5ACT
#define REP_P5ACT 1
#endif
#ifndef REP_SYNC
#define REP_SYNC 1
#endif
__global__ void __launch_bounds__(NTHREADS, 2) mk_fwd(Args a) {
    extern __shared__ __attribute__((aligned(16))) unsigned char lds[];
    const int G = gridDim.x, bid = blockIdx.x, NGW = G * NWAVES;
    int tid, lane, wave, gw;
    int wave_s; { const int w_ = (int)(threadIdx.x >> 6); asm volatile("s_nop 1\n\tv_readfirstlane_b32 %0, %1\n\ts_nop 3" : "=s"(wave_s) : "v"(w_)); }
#define REFRESH_IDS() do { int l_; asm volatile("v_mbcnt_lo_u32_b32 %0, -1, 0\n\tv_mbcnt_hi_u32_b32 %0, -1, %0" : "=&v"(l_)); lane = l_; wave = wave_s; tid = wave_s * 64 + l_; gw = bid * NWAVES + wave; } while (0)
    REFRESH_IDS();
    { volatile LAS unsigned* st = (volatile LAS unsigned*)((LAS unsigned char*)lds + MISC_OFF); if (tid < 2) st[tid] = 0u; }
    __syncthreads();
    const XcdBarrier xbar = xcd_barrier_post((unsigned*)(a.ws + WS_CTL) + CW_BAR, (volatile LAS unsigned*)((LAS unsigned char*)lds + MISC_OFF), tid);
#define GRID_BAR() do { xcd_barrier(xbar, tid); REFRESH_IDS(); } while (0)
    const float* x = a.in[0]; const float* g1 = a.in[1]; const float* w_in = a.in[2];
    const float* qg = a.in[3]; const float* kg = a.in[4]; const float* pool_w = a.in[5]; const float* pool_scale = a.in[6];
    const float* w_out = a.in[7]; const float* g2 = a.in[8]; const float* wq = a.in[9]; const float* sk = a.in[10];
    const float* pu = a.in[11]; const float* pv = a.in[12];
    unsigned char* ws = a.ws; float* out = a.out;
    float* rs1 = (float*)(ws + WS_RS1); float* ss2 = (float*)(ws + WS_SS2); float2* rope = (float2*)(ws + WS_ROPE); unsigned char* XQ = ws + WS_P;
    bf16_t* xb = (bf16_t*)(ws + WS_XB); bf16_t* Q = (bf16_t*)(ws + WS_Q); bf16_t* Kb = (bf16_t*)(ws + WS_K); bf16_t* V = (bf16_t*)(ws + WS_V); bf16_t* P = (bf16_t*)(ws + WS_P);
    bf16_t* mix = (bf16_t*)(ws + WS_MIX); bf16_t* xb2 = (bf16_t*)(ws + WS_XB2);
    int* idx = (int*)(ws + WS_IDX); float* gate = (float*)(ws + WS_GATE);
    bf16_t* WinT = (bf16_t*)(ws + WS_WIN); bf16_t* WoutT = (bf16_t*)(ws + WS_WOUT); bf16_t* WscT = (bf16_t*)(ws + WS_WSC);
    unsigned char* U8 = ws + WS_U16; unsigned char* V8 = ws + WS_V16;
    LAS unsigned char* ldsp = (LAS unsigned char*)lds;

    for (int rep0 = 0; rep0 < REP_P0; ++rep0) {
    for (int e = bid * NTHREADS + tid; e < S * 32; e += G * NTHREADS) {
        const int pos = e >> 5, j = e & 31; const double f = pow(10000.0, -(double)(2 * j) / 64.0); const double ang = (double)pos * f;
        { const int fq_ = j >> 3, n_ = (j >> 2) & 1, w_ = (j >> 1) & 1, k_ = j & 1, tile_ = pos >> 8, fr_ = (pos >> 4) & 15, c_ = pos & 15;
          rope[(size_t)((((tile_ * 16 + c_) * 2 + n_) * 2 + w_) * 64 + (16 * fq_ + fr_)) * 2 + k_] = make_float2((float)cos(ang), (float)sin(ang)); } }
    for (int row = gw; row < T; row += NGW) {
        const float4* xr = (const float4*)(x + (size_t)row * D); float4 v[4]; float ss = 0.f;
#pragma unroll
        for (int j = 0; j < 4; ++j) { const f32x4 t_ = __builtin_nontemporal_load((const f32x4*)xr + lane + 64 * j); v[j] = make_float4(t_[0], t_[1], t_[2], t_[3]); ss +=        v[j].x * v[j].x + v[j].y * v[j].y + v[j].z * v[j].z + v[j].w * v[j].w; }
        ss = wave_sum(ss);
        if (lane == 0) rs1[row] = 1.0f / sqrtf(ss * (1.0f / D) + EPS);
        uint2* o = (uint2*)(xb + (size_t)row * D);
#pragma unroll
        for (int j = 0; j < 4; ++j) o[lane + 64 * j] = make_uint2(f2bf(v[j].x) | (f2bf(v[j].y) << 16), f2bf(v[j].z) | (f2bf(v[j].w) << 16)); }
    {
        LAS float* scr = (LAS float*)(ldsp + wave * 16384);
        for (int it = gw; it < 1024 + 256; it += NGW) {
            if (it < 1024) { const int kb = it >> 6, nb = it & 63; p0_transpose_item<true>(w_in, 2048, win_src_col(32 * nb), g1, WinT, 1024, 64 * kb, 32 * nb, scr, lane); }
            else { const int r = it - 1024, kb = r >> 5, nb = r & 31; p0_transpose_item<false>(w_out, 1024, 32 * nb, nullptr, WoutT, 1024, 64 * kb, 32 * nb, scr, lane); }
        }
    }
    __syncthreads();
    for (int item = G - 1 - bid; item < 64; item += G) p0_poolfold_item(item, tid, (LAS float*)ldsp, w_out, pool_w, pool_scale, WoutT);
    for (int item = bid; item < 256; item += G) p0_wprime_item(item, tid, (LAS float*)ldsp, wq, sk, g2, WscT);
    __syncthreads(); }
    GRID_BAR();
    { pg8::Gemm g{xb, WinT, T, 2048, 1024}; pg8::StaticOrder So; So.init(T, 2048, G, bid);
      EpiProj E{rs1, qg, kg, rope, Q, Kb, V, P};
      for (int rep = 0; rep < REP_P1; ++rep) { pg8::gemm_phase<EpiProj, pg8::StaticOrder, true, true>(ldsp, g, So, E, tid); __syncthreads(); } }
    GRID_BAR();
    for (int rep = 0; rep < REP_ATT; ++rep)
    { const int per = (1024 + G - 1) / G;
      for (int j = 0; j < per; ++j) { const int bt = bid * per + j; if (bt >= 1024) break;
          const int pl_ = (G == 256) ? (8 * j + (bid & 7)) : (bt >> 5), sp_ = (G == 256) ? (bid >> 3) : (bt & 31); const int b_ = pl_ >> 3, h_ = pl_ & 7;
          attn_stage(ldsp, Kb, V, (size_t)(b_ * 8 + h_) * 8192 * 64, sp_, wave, lane);
          asm volatile("s_waitcnt vmcnt(0)" ::: "memory"); __syncthreads();
          { const int r0_ = rep == 0 ? (bt * 8 + wave) * 2 : -1;
            attn_task(b_, h_, sp_, wave, lane, ldsp, Q, Kb, V, mix, r0_, pu, pv, g2, U8, V8); attn_task(b_, h_, sp_, wave + 8, lane, ldsp, Q, Kb, V, mix, r0_ < 0 ? -1 : r0_ + 1, pu, pv, g2, U8, V8); }
          __syncthreads(); } }
    for (int rep = 0; rep < REP_POOL; ++rep) {
    if (NGW == 2048) {
        const int tile = gw >> 1;
        if ((gw & 1) == 0) { u32x4 a16[23], a2[9]; pooled_run_load<16, 8>(a16, tile, 3, lane, P); pooled_run_load<2, 8>(a2, tile, 0, lane, P); pooled_run_finish<16, 8>(a16, tile, 3, lane, mix); pooled_run_finish<2, 8>(a2, tile, 0, lane, mix); }
        else               { u32x4 a8[15], a4[11]; pooled_run_load<8, 8>(a8, tile, 2, lane, P);   pooled_run_load<4, 8>(a4, tile, 1, lane, P); pooled_run_finish<8, 8>(a8, tile, 2, lane, mix);   pooled_run_finish<4, 8>(a4, tile, 1, lane, mix); }
    } else
    for (int wt = gw, it_ = 0; wt < 32768; wt += NGW, ++it_) { const int g_ = (wt + it_) & 3, tq_ = wt >> 2;
        if (g_ == 0) pooled_task<2>(tq_, 0, lane, P, mix); else if (g_ == 1) pooled_task<4>(tq_, 1, lane, P, mix); else if (g_ == 2) pooled_task<8>(tq_, 2, lane, P, mix); else pooled_task<16>(tq_, 3, lane, P, mix); } }
    GRID_BAR();
    { pg8::Gemm g{mix, WoutT, T, 1024, 1024}; pg8::StaticOrder So; So.init(T, 1024, G, bid);
      EpiOut E{xb, out, xb2, ss2};
      for (int rep = 0; rep < REP_P3; ++rep) { pg8::gemm_phase<EpiOut, pg8::StaticOrder, true, true>(ldsp, g, So, E, tid); __syncthreads(); } }
    GRID_BAR();
    { pg8::StaticOrder So; So.init(T, 2048, G, bid); pg8::Gemm g{xb2, WscT, T, 2048, 1024}; EpiScores E{ss2, idx, gate, g, pg8::Unit{0, 0}, false};
      for (int rep = 0; rep < REP_P4; ++rep) { SingleUnit Su; bool have = So.next(0, Su.u);
      for (int i = 0; have; ++i) { pg8::Unit un; const bool hn = So.next(i + 1, un); E.nxt = un; E.has_next = hn;
          if (i == 0) pg8::gemm_phase<EpiScores, SingleUnit, false, true, false>(ldsp, g, Su, E, tid); else pg8::gemm_phase<EpiScores, SingleUnit, false, true, true>(ldsp, g, Su, E, tid);
          __syncthreads(); Su.u = un; have = hn; } } }
    REFRESH_IDS();
    { float gn[16];
#pragma unroll
      for (int k4 = 0; k4 < 4; ++k4) { const f32x4 gq = *(const f32x4*)(g2 + 16 * lane + 4 * k4); gn[4 * k4] = gq[0]; gn[4 * k4 + 1] = gq[1]; gn[4 * k4 + 2] = gq[2]; gn[4 * k4 + 3] = gq[3]; }
      XqIn xa, xb_; xq_load(xa, (size_t)gw, lane, ss2, xb2);
      for (int t = gw; t < T; t += 2 * NGW) {
          if (t + NGW < T) xq_load(xb_, (size_t)(t + NGW), lane, ss2, xb2);
          xq_token(xa, (size_t)t, lane, XQ, gn);
          if (t + NGW < T) { if (t + 2 * NGW < T) xq_load(xa, (size_t)(t + 2 * NGW), lane, ss2, xb2);
                             xq_token(xb_, (size_t)(t + NGW), lane, XQ, gn); } } }
    GRID_BAR();
    for (int rep = 1; rep < REP_SYNC; ++rep) { GRID_BAR(); }
    { float* part = (float*)(ws + WS_XB); float* actb = (float*)(ws + WS_V); unsigned* ctl = (unsigned*)(ws + WS_CTL);
      for (int rep = 0; rep < REP_P5A; ++rep) p5_sliced<0>(ctl + CW_CNTA + 2048 * rep, lane, out, xb2, XQ, idx, U8, part, ldsp + wave * 16384, ldsp + 131072 + wave * 1024, gate, (G == 256 && P5Ch<0>::NCH % 512 == 0) ? 8 * (bid >> 2) + wave : -1);
      GRID_BAR();
      p5_sliced<1>(ctl + CW_CNTB, lane, out, xb2, XQ, idx, V8, part, ldsp + wave * 16384, ldsp + 131072 + wave * 1024, gate, (G == 256 && P5Ch<1>::NCH % 512 == 0) ? 8 * (bid >> 2) + wave : -1); }
}

extern "C" void kernel_launch(void* const* d_in, const int* in_sizes, int n_in, void* d_out, int out_size, void* d_ws, size_t ws_size, hipStream_t stream) {
    static int grid_blocks = 0;
    if (grid_blocks == 0) {
        if (n_in != 13 || in_sizes[0] != T * D || out_size != T * D || ws_size < WS_END) { fprintf(stderr, "kernel_launch: unexpected shapes (n_in %d, in0 %d, out %d, ws %zu)\n", n_in, n_in > 0 ? in_sizes[0] : -1, out_size, ws_size); grid_blocks = -1; return; }
        int dev = 0, cus = 0, per_cu = 0;
        hipGetDevice(&dev); hipDeviceGetAttribute(&cus, hipDeviceAttributeMultiprocessorCount, dev);
        hipFuncSetAttribute((const void*)mk_fwd, hipFuncAttributeMaxDynamicSharedMemorySize, LDS_BYTES);
        hipOccupancyMaxActiveBlocksPerMultiprocessor(&per_cu, (const void*)mk_fwd, NTHREADS, LDS_BYTES);
        if (per_cu < 1) { fprintf(stderr, "kernel_launch: occupancy query says %d blocks per CU\n", per_cu); per_cu = 1; }
        if (per_cu > 1) per_cu = 1;
        grid_blocks = cus * per_cu;
        fprintf(stderr, "kernel_launch: %d CUs x %d = grid %d\n", cus, per_cu, grid_blocks);
    }
    if (grid_blocks < 0) return;
    if (hipMemsetAsync((char*)d_ws + WS_CTL, 0, CTL_ZERO_BYTES, stream) != hipSuccess) { fprintf(stderr, "kernel_launch: memset of the control words failed\n"); return; }
    Args a{};
    for (int i = 0; i < 13; ++i) a.in[i] = (const float*)d_in[i];
    a.out = (float*)d_out; a.ws = (unsigned char*)d_ws;
    void* args[] = {&a};
    hipError_t e = hipLaunchCooperativeKernel((const void*)mk_fwd, dim3(grid_blocks), dim3(NTHREADS), args, LDS_BYTES, stream);
    if (e != hipSuccess) fprintf(stderr, "cooperative launch failed: %s (grid %d)\n", hipGetErrorString(e), grid_blocks);
}
```
